# Optimizing an MI355X kernel written in HIP

```python
import math
import jax, jax.numpy as jnp
from jax import lax
import numpy as np

D_MODEL = 1024
BATCH = 16
SEQ = 2048
DEPTH = 2

DA_HEADS = 8
DA_HEAD_DIM = 64
DA_WIDTH = DA_HEADS * 2 * DA_HEAD_DIM
SSD_WIDTH = D_MODEL
SSD_HEAD_DIM = 64
SSD_HEADS = SSD_WIDTH // SSD_HEAD_DIM
SSD_GROUPS = 2
SSD_STATE = 128
SSD_CONV = 4
SSD_CHUNK = 128
SSD_CONV_DIM = SSD_WIDTH + 2 * SSD_GROUPS * SSD_STATE
SW_HEADS = 16
SW_KV_HEADS = 2
SW_GQ = SW_HEADS // SW_KV_HEADS
SW_HEAD_DIM = 64
SW_WIDTH = SW_HEADS * SW_HEAD_DIM
SW_KV_WIDTH = SW_KV_HEADS * SW_HEAD_DIM
WINDOW = 128
Q_BLOCK = 128
EPS = 1e-5

N_EVEN = (DEPTH + 1) // 2
N_ODD = DEPTH // 2
EVEN_IN = 4 * DA_WIDTH + SSD_WIDTH + SSD_CONV_DIM + SSD_HEADS
EVEN_SPLITS = [DA_WIDTH, 2 * DA_WIDTH, 3 * DA_WIDTH, 4 * DA_WIDTH,
               4 * DA_WIDTH + SSD_WIDTH, 4 * DA_WIDTH + SSD_WIDTH + SSD_CONV_DIM]
ODD_IN = 2 * SW_WIDTH + 2 * SW_KV_WIDTH
ODD_SPLITS = [SW_WIDTH, SW_WIDTH + SW_KV_WIDTH, SW_WIDTH + 2 * SW_KV_WIDTH]

kernel_name = "hybrid_diffattn_ssd_swa_block"


def rmsnorm(x, w):
    xf = x.astype(jnp.float32)
    y = xf * lax.rsqrt(jnp.mean(xf * xf, axis=-1, keepdims=True) + EPS)
    return (y * w.astype(jnp.float32)).astype(x.dtype)


def alibi_slopes(n):
    return jnp.exp2(-8.0 * jnp.arange(1, n + 1, dtype=jnp.float32) / n)


def diff_attention(q, k, v, lam, slopes):
    b, s = q.shape[:2]
    nb = s // Q_BLOCK
    scale = DA_HEAD_DIM ** -0.5
    qb = q.reshape(b, nb, Q_BLOCK, DA_HEADS, 2, DA_HEAD_DIM).transpose(1, 0, 2, 3, 4, 5)
    kpos = jnp.arange(s)

    def block(args):
        qi, n = args
        qpos = n * Q_BLOCK + jnp.arange(Q_BLOCK)
        dist = qpos[:, None] - kpos[None, :]
        logits = jnp.einsum('bqhmd,bshmd->bhmqs', qi, k).astype(jnp.float32) * scale
        logits = logits - slopes[None, :, None, None, None] * dist.astype(jnp.float32)[None, None, None]
        logits = jnp.where((dist >= 0)[None, None, None], logits, -jnp.inf)
        p = jax.nn.softmax(logits, axis=-1)
        attn = p[:, :, 0] - lam * p[:, :, 1]
        return jnp.einsum('bhqs,bshe->bqhe', attn.astype(v.dtype), v)

    out = lax.map(block, (qb, jnp.arange(nb)))
    return out.transpose(1, 0, 2, 3, 4).reshape(b, s, DA_HEADS, 2 * DA_HEAD_DIM)


def causal_dwconv(x, w, bias):
    c = x.shape[-1]
    y = lax.conv_general_dilated(x, w[:, None, :].astype(x.dtype), window_strides=(1,),
                                 padding=[(SSD_CONV - 1, 0)],
                                 dimension_numbers=('NWC', 'WIO', 'NWC'),
                                 feature_group_count=c)
    return y + bias.astype(x.dtype)


def segsum(a):
    cs = jnp.cumsum(a, axis=-1)
    diff = cs[..., :, None] - cs[..., None, :]
    n = a.shape[-1]
    mask = jnp.tril(jnp.ones((n, n), dtype=bool))
    return jnp.where(mask, diff, -jnp.inf)


def ssd_scan(xh, dt, A, bm, cm):
    b, s = xh.shape[:2]
    nc = s // SSD_CHUNK
    hpg = SSD_HEADS // SSD_GROUPS
    dtype = xh.dtype
    xdt = (xh * dt[..., None].astype(dtype)).reshape(b, nc, SSD_CHUNK, SSD_GROUPS, hpg, SSD_HEAD_DIM)
    bc = bm.reshape(b, nc, SSD_CHUNK, SSD_GROUPS, SSD_STATE)
    cc = cm.reshape(b, nc, SSD_CHUNK, SSD_GROUPS, SSD_STATE)
    dA = (dt * A).reshape(b, nc, SSD_CHUNK, SSD_GROUPS, hpg).transpose(0, 1, 3, 4, 2)
    cs = jnp.cumsum(dA, axis=-1)
    lmat = jnp.exp(segsum(dA)).astype(dtype)
    cb = jnp.einsum('bclgn,bcsgn->bcgls', cc, bc)
    y_diag = jnp.einsum('bcgjls,bcsgjp->bclgjp', cb[:, :, :, None] * lmat, xdt)
    decay_states = jnp.exp(cs[..., -1:] - cs).astype(dtype)
    states = jnp.einsum('bclgn,bcgjl,bclgjp->bcgjpn', bc, decay_states, xdt)
    chunk_decay = jnp.exp(cs[..., -1]).astype(dtype)

    def step(h, inp):
        st, dec = inp
        return h * dec[..., None, None] + st, h

    h0 = jnp.zeros((b, SSD_GROUPS, hpg, SSD_HEAD_DIM, SSD_STATE), dtype)
    _, prev = lax.scan(step, h0, (states.transpose(1, 0, 2, 3, 4, 5), chunk_decay.transpose(1, 0, 2, 3)))
    prev = prev.transpose(1, 0, 2, 3, 4, 5)
    y_off = jnp.einsum('bclgn,bcgjpn,bcgjl->bclgjp', cc, prev, jnp.exp(cs).astype(dtype))
    return (y_diag + y_off).reshape(b, s, SSD_HEADS, SSD_HEAD_DIM)


def sliding_window_attention(q, k, v, sinks, slopes):
    b, s = q.shape[:2]
    nb = s // WINDOW
    scale = SW_HEAD_DIM ** -0.5
    qb = q.reshape(b, nb, WINDOW, SW_KV_HEADS, SW_GQ, SW_HEAD_DIM)
    kb = k.reshape(b, nb, WINDOW, SW_KV_HEADS, SW_HEAD_DIM)
    vb = v.reshape(b, nb, WINDOW, SW_KV_HEADS, SW_HEAD_DIM)
    pad = ((0, 0), (1, 0), (0, 0), (0, 0), (0, 0))
    kk = jnp.concatenate([jnp.pad(kb, pad)[:, :-1], kb], axis=2)
    vv = jnp.concatenate([jnp.pad(vb, pad)[:, :-1], vb], axis=2)
    logits = jnp.einsum('bnqkgd,bnskd->bnkgqs', qb, kk).astype(jnp.float32) * scale
    qrel = jnp.arange(WINDOW) + WINDOW
    krel = jnp.arange(2 * WINDOW)
    dist = qrel[:, None] - krel[None, :]
    key_abs = (jnp.arange(nb) * WINDOW - WINDOW)[:, None] + krel[None, :]
    valid = ((dist >= 0) & (dist < WINDOW))[None] & (key_abs >= 0)[:, None, :]
    sl = slopes.reshape(SW_KV_HEADS, SW_GQ)[None, None, :, :, None, None]
    logits = logits - sl * dist.astype(jnp.float32)
    logits = jnp.where(valid[None, :, None, None], logits, -jnp.inf)
    sink = jnp.broadcast_to(sinks.astype(jnp.float32).reshape(SW_KV_HEADS, SW_GQ)[None, None, :, :, None, None],
                            logits.shape[:-1] + (1,))
    p = jax.nn.softmax(jnp.concatenate([logits, sink], axis=-1), axis=-1)[..., :-1]
    out = jnp.einsum('bnkgqs,bnskd->bnqkgd', p.astype(v.dtype), vv)
    return out.reshape(b, s, SW_WIDTH)


def even_layer(h, w_in, conv_w, conv_b, dt_bias, a_log, d_skip, ssd_norm_w,
               lq1, lk1, lq2, lk2, subln_w, w_out, lambda_init):
    b, s, _ = h.shape
    proj = h @ w_in
    q, k, v, g_a, z, xbc, dt_raw = jnp.split(proj, EVEN_SPLITS, axis=-1)
    q = q.reshape(b, s, DA_HEADS, 2, DA_HEAD_DIM)
    k = k.reshape(b, s, DA_HEADS, 2, DA_HEAD_DIM)
    v = v.reshape(b, s, DA_HEADS, 2 * DA_HEAD_DIM)
    f32 = jnp.float32
    lam = (jnp.exp(jnp.sum(lq1.astype(f32) * lk1.astype(f32)))
           - jnp.exp(jnp.sum(lq2.astype(f32) * lk2.astype(f32))) + lambda_init)
    attn = diff_attention(q, k, v, lam, alibi_slopes(DA_HEADS))
    attn = rmsnorm(attn, subln_w) * (1.0 - lambda_init)
    y_a = attn.reshape(b, s, DA_WIDTH) * jax.nn.silu(g_a)
    xbc = jax.nn.silu(causal_dwconv(xbc, conv_w, conv_b))
    xs, bm, cm = jnp.split(xbc, [SSD_WIDTH, SSD_WIDTH + SSD_GROUPS * SSD_STATE], axis=-1)
    xh = xs.reshape(b, s, SSD_HEADS, SSD_HEAD_DIM)
    dt = jax.nn.softplus(dt_raw.astype(f32) + dt_bias.astype(f32))
    A = -jnp.exp(a_log.astype(f32))
    y = ssd_scan(xh, dt, A, bm.reshape(b, s, SSD_GROUPS, SSD_STATE), cm.reshape(b, s, SSD_GROUPS, SSD_STATE))
    y = y + xh * d_skip[:, None].astype(xh.dtype)
    y = y.reshape(b, s, SSD_WIDTH) * jax.nn.silu(z)
    y_b = rmsnorm(y.reshape(b, s, SSD_GROUPS, SSD_WIDTH // SSD_GROUPS),
                  ssd_norm_w.reshape(SSD_GROUPS, SSD_WIDTH // SSD_GROUPS)).reshape(b, s, SSD_WIDTH)
    return jnp.concatenate([y_a, y_b], axis=-1) @ w_out


def odd_layer(h, w_in, b_in, sinks, w_out):
    b, s, _ = h.shape
    proj = h @ w_in + b_in
    q, k, v, g = jnp.split(proj, ODD_SPLITS, axis=-1)
    q = q.reshape(b, s, SW_KV_HEADS, SW_GQ, SW_HEAD_DIM)
    k = k.reshape(b, s, SW_KV_HEADS, SW_HEAD_DIM)
    v = v.reshape(b, s, SW_KV_HEADS, SW_HEAD_DIM)
    o = sliding_window_attention(q, k, v, sinks, alibi_slopes(SW_HEADS))
    return (o * jax.nn.silu(g)) @ w_out


def setup_inputs(seed: int = 0) -> dict:
    key = jax.random.key(seed)
    ks = jax.random.split(key, 24)
    f32 = jnp.float32

    def nrm(k, shape, scale):
        return jax.random.normal(k, shape, f32) * scale

    dt0 = jnp.exp(jax.random.uniform(ks[5], (N_EVEN, SSD_HEADS), f32, math.log(1e-3), math.log(1e-1)))
    return {
        "x": nrm(ks[0], (BATCH, SEQ, D_MODEL), 1.0),
        "norm_a": 1.0 + nrm(ks[1], (N_EVEN, D_MODEL), 0.02),
        "w_in_a": nrm(ks[2], (N_EVEN, D_MODEL, EVEN_IN), D_MODEL ** -0.5),
        "conv_w_a": nrm(ks[3], (N_EVEN, SSD_CONV, SSD_CONV_DIM), SSD_CONV ** -0.5),
        "conv_b_a": nrm(ks[4], (N_EVEN, SSD_CONV_DIM), 0.02),
        "dt_bias_a": dt0 + jnp.log(-jnp.expm1(-dt0)),
        "a_log_a": jnp.log(jax.random.uniform(ks[6], (N_EVEN, SSD_HEADS), f32, 1.0, 16.0)),
        "d_skip_a": 1.0 + nrm(ks[7], (N_EVEN, SSD_HEADS), 0.1),
        "ssd_norm_a": 1.0 + nrm(ks[8], (N_EVEN, SSD_WIDTH), 0.02),
        "lambda_q1_a": nrm(ks[9], (N_EVEN, DA_HEAD_DIM), 0.1),
        "lambda_k1_a": nrm(ks[10], (N_EVEN, DA_HEAD_DIM), 0.1),
        "lambda_q2_a": nrm(ks[11], (N_EVEN, DA_HEAD_DIM), 0.1),
        "lambda_k2_a": nrm(ks[12], (N_EVEN, DA_HEAD_DIM), 0.1),
        "subln_a": 1.0 + nrm(ks[13], (N_EVEN, 2 * DA_HEAD_DIM), 0.02),
        "w_out_a": nrm(ks[14], (N_EVEN, DA_WIDTH + SSD_WIDTH, D_MODEL), (DA_WIDTH + SSD_WIDTH) ** -0.5),
        "norm_c": 1.0 + nrm(ks[15], (N_ODD, D_MODEL), 0.02),
        "w_in_c": nrm(ks[16], (N_ODD, D_MODEL, ODD_IN), D_MODEL ** -0.5),
        "b_in_c": nrm(ks[17], (N_ODD, ODD_IN), 0.02),
        "sinks_c": nrm(ks[18], (N_ODD, SW_HEADS), 1.0),
        "w_out_c": nrm(ks[19], (N_ODD, SW_WIDTH, D_MODEL), SW_WIDTH ** -0.5),
        "final_norm": 1.0 + nrm(ks[20], (D_MODEL,), 0.02),
    }


def reference(x, norm_a, w_in_a, conv_w_a, conv_b_a, dt_bias_a, a_log_a, d_skip_a, ssd_norm_a,
              lambda_q1_a, lambda_k1_a, lambda_q2_a, lambda_k2_a, subln_a, w_out_a,
              norm_c, w_in_c, b_in_c, sinks_c, w_out_c, final_norm):
    for i in range(DEPTH):
        j = i // 2
        if i % 2 == 0:
            lambda_init = 0.8 - 0.6 * math.exp(-0.3 * i)
            x = x + even_layer(rmsnorm(x, norm_a[j]), w_in_a[j], conv_w_a[j], conv_b_a[j],
                               dt_bias_a[j], a_log_a[j], d_skip_a[j], ssd_norm_a[j],
                               lambda_q1_a[j], lambda_k1_a[j], lambda_q2_a[j], lambda_k2_a[j],
                               subln_a[j], w_out_a[j], lambda_init)
        else:
            x = x + odd_layer(rmsnorm(x, norm_c[j]), w_in_c[j], b_in_c[j], sinks_c[j], w_out_c[j])
    return rmsnorm(x, final_norm)
```

```cpp
#include <hip/hip_runtime.h>
#include <cstdio>
#include <cstdint>
#include <cmath>

typedef unsigned short bf16_t;
typedef unsigned u32x4 __attribute__((ext_vector_type(4)));
typedef float f32x4 __attribute__((ext_vector_type(4)));

constexpr int BATCH = 16, SEQ = 2048, DM = 1024, MROWS = BATCH * SEQ;
constexpr int EVEN_IN = 6672, PROJ_P = 6656, NA_PAD = 6912;
constexpr int CQ = 0, CK = 1024, CV = 2048, CGA = 3072, CZ = 4096, CXS = 5120, CBM = 6144, CCM = 6400, CDT = 6656;
constexpr int ODD_IN = 2304;
constexpr int OQ = 0, OK_ = 1024, OV = 1152, OG_ = 1280;
constexpr float EPS = 1e-5f;
constexpr float LAMBDA_INIT = 0.2f;
constexpr float LOG2E = 1.4426950408889634f;

constexpr size_t MiB = 1u << 20;
constexpr size_t WS_CTL = 0;
constexpr size_t WS_WA = 1 * MiB;
constexpr size_t WS_WOA = 15 * MiB;
constexpr size_t WS_WC = 19 * MiB;
constexpr size_t WS_WOC = 24 * MiB;
constexpr size_t WS_DT = 26 * MiB;
constexpr size_t WS_SSQ = 28 * MiB;
constexpr size_t WS_RSTD0 = 30 * MiB;
constexpr size_t WS_RSTD1 = 30 * MiB + 256 * 1024;
constexpr size_t WS_PROJ = 32 * MiB;
constexpr size_t WS_X1 = 32 * MiB;
constexpr size_t WS_XB1 = 160 * MiB;
constexpr size_t WS_PROJC = 224 * MiB;
constexpr size_t WS_OG = 368 * MiB;
constexpr size_t WS_END = 448 * MiB;

__device__ __forceinline__ unsigned f2bf(float f) { unsigned u = __builtin_bit_cast(unsigned, f); return (u + 0x7fffu + ((u >> 16) & 1u)) >> 16; }
__device__ __forceinline__ float bf2f(unsigned h) { return __builtin_bit_cast(float, h << 16); }
__device__ __forceinline__ unsigned pk2(float lo, float hi) { return f2bf(lo) | (f2bf(hi) << 16); }
__device__ __forceinline__ float silu_f(float v) { return v / (1.f + __expf(-v)); }
__device__ __forceinline__ float wave_sum(float v) {
#pragma unroll
    for (int o = 1; o < 64; o <<= 1) v += __shfl_xor(v, o);
    return v;
}

__global__ void __launch_bounds__(256) k_wt(const float* W, const float* s, bf16_t* Wt, int K, int N, int Npad) {
    __shared__ float tile[32][33];
    const int k0 = blockIdx.y * 32, n0 = blockIdx.x * 32, tx = threadIdx.x & 31, ty = threadIdx.x >> 5;
    for (int i = ty; i < 32; i += 8) { const int k = k0 + i, n = n0 + tx; float v = 0.f; if (n < N) { v = W[(size_t)k * N + n]; if (s) v *= s[k]; } tile[i][tx] = v; }
    __syncthreads();
    for (int i = ty; i < 32; i += 8) { const int n = n0 + i, k = k0 + tx; if (n < Npad) Wt[(size_t)n * K + k] = (bf16_t)f2bf(tile[tx][i]); }
}
__global__ void __launch_bounds__(256) k_xprep(const float* x, bf16_t* xb, float* rstd) {
    const int row = blockIdx.x * 4 + (threadIdx.x >> 6), lane = threadIdx.x & 63;
    const f32x4* xr = (const f32x4*)(x + (size_t)row * DM) + lane; float s = 0.f;
    unsigned long long* o8 = (unsigned long long*)(xb + (size_t)row * DM) + lane;
#pragma unroll
    for (int j = 0; j < 4; ++j) { const f32x4 v = xr[64 * j]; s += v.x * v.x + v.y * v.y + v.z * v.z + v.w * v.w; o8[64 * j] = (unsigned long long)pk2(v.x, v.y) | ((unsigned long long)pk2(v.z, v.w) << 32); }
    s = wave_sum(s);
    if (lane == 0) rstd[row] = 1.f / sqrtf(s * (1.f / DM) + EPS);
}
template <class Epi>
__global__ void __launch_bounds__(256) k_gemm(const bf16_t* A, const bf16_t* Bt, int K, Epi epi) {
    __shared__ __attribute__((aligned(16))) float As[32][68]; __shared__ __attribute__((aligned(16))) float Bs[32][68];
    const int tx = threadIdx.x & 15, ty = threadIdx.x >> 4, m0 = blockIdx.y * 64, n0 = blockIdx.x * 64;
    const int lr = threadIdx.x >> 2, lk = (threadIdx.x & 3) * 8;
    float acc[4][4];
#pragma unroll
    for (int i = 0; i < 4; ++i)
#pragma unroll
        for (int j = 0; j < 4; ++j) acc[i][j] = 0.f;
    for (int k0 = 0; k0 < K; k0 += 32) {
        const u32x4 av = *(const u32x4*)(A + (size_t)(m0 + lr) * K + k0 + lk), bv = *(const u32x4*)(Bt + (size_t)(n0 + lr) * K + k0 + lk);
        __syncthreads();
#pragma unroll
        for (int i = 0; i < 4; ++i) { As[lk + 2 * i][lr] = bf2f(av[i] & 0xffffu); As[lk + 2 * i + 1][lr] = bf2f(av[i] >> 16); Bs[lk + 2 * i][lr] = bf2f(bv[i] & 0xffffu); Bs[lk + 2 * i + 1][lr] = bf2f(bv[i] >> 16); }
        __syncthreads();
#pragma unroll 8
        for (int kk = 0; kk < 32; ++kk) {
            const f32x4 a = *(const f32x4*)&As[kk][ty * 4], b = *(const f32x4*)&Bs[kk][tx * 4];
#pragma unroll
            for (int i = 0; i < 4; ++i)
#pragma unroll
                for (int j = 0; j < 4; ++j) acc[i][j] += a[i] * b[j];
        }
    }
#pragma unroll
    for (int i = 0; i < 4; ++i)
#pragma unroll
        for (int j = 0; j < 4; ++j) epi(m0 + ty * 4 + i, n0 + tx * 4 + j, acc[i][j]);
}
struct EpiProjA { bf16_t* proj; float* dt; const float* rstd;
    __device__ void operator()(int r, int c, float v) const { v *= rstd[r]; if (c < PROJ_P) proj[(size_t)r * PROJ_P + c] = (bf16_t)f2bf(v); else if (c < EVEN_IN) dt[(size_t)r * 16 + (c - PROJ_P)] = v; } };
struct EpiRes1 { const float* xin; float* xout; bf16_t* xb;
    __device__ void operator()(int r, int c, float v) const { const size_t i = (size_t)r * DM + c; const float o = xin[i] + v; xout[i] = o; if (xb) xb[i] = (bf16_t)f2bf(o); } };
struct EpiProjC { bf16_t* proj; const float* rstd; const float* bias;
    __device__ void operator()(int r, int c, float v) const { proj[(size_t)r * ODD_IN + c] = (bf16_t)f2bf(v * rstd[r] + bias[c]); } };

__global__ void __launch_bounds__(256) k_rowrstd(const float* x, float* rstd) {
    const int row = blockIdx.x * 4 + (threadIdx.x >> 6), lane = threadIdx.x & 63;
    const f32x4* xr = (const f32x4*)(x + (size_t)row * DM) + lane; float s = 0.f;
#pragma unroll
    for (int j = 0; j < 4; ++j) { const f32x4 v = xr[64 * j]; s += v.x * v.x + v.y * v.y + v.z * v.z + v.w * v.w; }
    s = wave_sum(s);
    if (lane == 0) rstd[row] = 1.f / sqrtf(s * (1.f / DM) + EPS);
}
__global__ void __launch_bounds__(256) k_final(const float* x, const float* w, float* out) {
    const int row = blockIdx.x * 4 + (threadIdx.x >> 6), lane = threadIdx.x & 63;
    const f32x4* xr = (const f32x4*)(x + (size_t)row * DM) + lane; f32x4 v[4]; float s = 0.f;
#pragma unroll
    for (int j = 0; j < 4; ++j) { v[j] = xr[64 * j]; s += v[j].x * v[j].x + v[j].y * v[j].y + v[j].z * v[j].z + v[j].w * v[j].w; }
    s = wave_sum(s); const float r = 1.f / sqrtf(s * (1.f / DM) + EPS);
    f32x4* o = (f32x4*)(out + (size_t)row * DM) + lane; const f32x4* wr = (const f32x4*)w + lane;
#pragma unroll
    for (int j = 0; j < 4; ++j) o[64 * j] = v[j] * r * wr[64 * j];
}

__global__ void __launch_bounds__(256) k_diffattn(const bf16_t* proj, const float* lq1, const float* lk1, const float* lq2, const float* lk2, const float* subln, bf16_t* Y) {
    const int qb = blockIdx.x, h = blockIdx.y, b = blockIdx.z, qi = threadIdx.x >> 2, eq = threadIdx.x & 3;
    const int qpos = qb * 64 + qi; const size_t row = (size_t)b * SEQ + qpos;
    float s1 = 0.f, s2 = 0.f; for (int i = 0; i < 64; ++i) { s1 += lq1[i] * lk1[i]; s2 += lq2[i] * lk2[i]; }
    const float lam = __expf(s1) - __expf(s2) + LAMBDA_INIT;
    const float slope = exp2f(-(float)(h + 1));
    float q0[16], q1[16];
    { const bf16_t* qp = proj + row * PROJ_P + CQ + h * 128 + eq * 16;
#pragma unroll
      for (int i = 0; i < 16; ++i) { q0[i] = bf2f(qp[i]); q1[i] = bf2f(qp[64 + i]); } }
    float o0[32], o1[32];
#pragma unroll
    for (int i = 0; i < 32; ++i) { o0[i] = 0.f; o1[i] = 0.f; }
    float m0 = -INFINITY, m1 = -INFINITY, l0 = 0.f, l1 = 0.f;
    const int jmax = qb * 64 + 63;
    for (int j = 0; j <= jmax; ++j) {
        const bf16_t* kp = proj + ((size_t)b * SEQ + j) * PROJ_P + CK + h * 128 + eq * 16;
        float d0 = 0.f, d1 = 0.f;
#pragma unroll
        for (int i = 0; i < 16; ++i) { d0 += q0[i] * bf2f(kp[i]); d1 += q1[i] * bf2f(kp[64 + i]); }
        d0 += __shfl_xor(d0, 1); d0 += __shfl_xor(d0, 2); d1 += __shfl_xor(d1, 1); d1 += __shfl_xor(d1, 2);
        if (j <= qpos) {
            const float bias = slope * (float)(qpos - j);
            const float a0 = d0 * 0.125f - bias, a1 = d1 * 0.125f - bias;
            const float n0 = fmaxf(m0, a0), n1 = fmaxf(m1, a1);
            const float c0 = __expf(m0 - n0), c1 = __expf(m1 - n1), p0 = __expf(a0 - n0), p1 = __expf(a1 - n1);
            m0 = n0; m1 = n1; l0 = l0 * c0 + p0; l1 = l1 * c1 + p1;
            const bf16_t* vp = proj + ((size_t)b * SEQ + j) * PROJ_P + CV + h * 128 + eq * 32;
#pragma unroll
            for (int i = 0; i < 32; ++i) { const float v = bf2f(vp[i]); o0[i] = o0[i] * c0 + p0 * v; o1[i] = o1[i] * c1 + p1 * v; }
        }
    }
    const float i0 = 1.f / l0, i1 = lam / l1; float ss = 0.f;
#pragma unroll
    for (int i = 0; i < 32; ++i) { o0[i] = o0[i] * i0 - o1[i] * i1; ss += o0[i] * o0[i]; }
    ss += __shfl_xor(ss, 1); ss += __shfl_xor(ss, 2);
    const float r = (1.f - LAMBDA_INIT) / sqrtf(ss * (1.f / 128.f) + EPS);
    const bf16_t* gp = proj + row * PROJ_P + CGA + h * 128 + eq * 32; bf16_t* yp = Y + row * 2048 + h * 128 + eq * 32;
#pragma unroll
    for (int i = 0; i < 32; ++i) yp[i] = (bf16_t)f2bf(o0[i] * r * subln[eq * 32 + i] * silu_f(bf2f(gp[i])));
}

__global__ void __launch_bounds__(256) k_ssd(const bf16_t* proj, const float* dtraw, const float* conv_w, const float* conv_b, const float* dt_bias, const float* a_log, const float* d_skip,
                                              bf16_t* Y, float* ssq) {
    __shared__ float sB[128], sC[128], sRed[4];
    const int hd = blockIdx.x, b = blockIdx.y, g = hd >> 3, t = threadIdx.x, p = t >> 2, nq = t & 3;
    const int cbc = (t < 128) ? (1024 + g * 128 + t) : (1024 + 256 + g * 128 + (t - 128));
    const int cx = hd * 64 + p;
    float wbc[4], wx[4];
#pragma unroll
    for (int j = 0; j < 4; ++j) { wbc[j] = conv_w[j * 1536 + cbc]; wx[j] = conv_w[j * 1536 + cx]; }
    const float bbc = conv_b[cbc], bx = conv_b[cx];
    const float A = -__expf(a_log[hd]), dtb = dt_bias[hd], Dk = d_skip[hd];
    float hbc[3] = {0.f, 0.f, 0.f}, hx[3] = {0.f, 0.f, 0.f};
    float st[32];
#pragma unroll
    for (int i = 0; i < 32; ++i) st[i] = 0.f;
    for (int ts = 0; ts < SEQ; ++ts) {
        const size_t row = (size_t)b * SEQ + ts; const bf16_t* pr = proj + row * PROJ_P;
        const float rbc = bf2f(pr[CXS + cbc]);
        const float vbc = silu_f(wbc[0] * hbc[0] + wbc[1] * hbc[1] + wbc[2] * hbc[2] + wbc[3] * rbc + bbc);
        hbc[0] = hbc[1]; hbc[1] = hbc[2]; hbc[2] = rbc;
        if (t < 128) sB[t] = bf2f(f2bf(vbc)); else sC[t - 128] = bf2f(f2bf(vbc));
        const float rx = bf2f(pr[CXS + cx]);
        const float vx = bf2f(f2bf(silu_f(wx[0] * hx[0] + wx[1] * hx[1] + wx[2] * hx[2] + wx[3] * rx + bx)));
        hx[0] = hx[1]; hx[1] = hx[2]; hx[2] = rx;
        const float dr = dtraw[row * 16 + hd] + dtb; const float dt = (dr > 20.f) ? dr : log1pf(__expf(dr));
        const float dec = __expf(dt * A), dtx = dt * vx;
        __syncthreads();
        float y = 0.f;
#pragma unroll
        for (int i = 0; i < 32; ++i) { st[i] = st[i] * dec + dtx * sB[nq * 32 + i]; y += sC[nq * 32 + i] * st[i]; }
        y += __shfl_xor(y, 1); y += __shfl_xor(y, 2);
        const float z = bf2f(pr[CZ + hd * 64 + p]);
        const float yz = (y + Dk * vx) * silu_f(z);
        float q = (nq == 0) ? yz * yz : 0.f; q = wave_sum(q);
        if ((t & 63) == 0) sRed[t >> 6] = q;
        if (nq == 0) Y[row * 2048 + 1024 + hd * 64 + p] = (bf16_t)f2bf(yz);
        __syncthreads();
        if (t == 0) ssq[row * 16 + hd] = sRed[0] + sRed[1] + sRed[2] + sRed[3];
    }
}
__global__ void __launch_bounds__(256) k_ssdnorm(bf16_t* Y, const float* ssq, const float* w) {
    const int row = blockIdx.x * 4 + (threadIdx.x >> 6), lane = threadIdx.x & 63;
    const float* sq = ssq + (size_t)row * 16;
#pragma unroll
    for (int g = 0; g < 2; ++g) {
        float s = 0.f;
#pragma unroll
        for (int i = 0; i < 8; ++i) s += sq[g * 8 + i];
        const float r = 1.f / sqrtf(s * (1.f / 512.f) + EPS);
        u32x4* yp = (u32x4*)(Y + (size_t)row * 2048 + 1024 + g * 512) + lane; const float* wp = w + g * 512 + lane * 8;
        u32x4 v = *yp;
#pragma unroll
        for (int i = 0; i < 4; ++i) v[i] = pk2(bf2f(v[i] & 0xffffu) * r * wp[2 * i], bf2f(v[i] >> 16) * r * wp[2 * i + 1]);
        *yp = v;
    }
}
__global__ void __launch_bounds__(256) k_swa(const bf16_t* projc, const float* sinks, bf16_t* OGb) {
    const int qpos = blockIdx.x * 256 + threadIdx.x, h = blockIdx.y, b = blockIdx.z, kvh = h >> 3;
    const size_t row = (size_t)b * SEQ + qpos;
    const float slope = exp2f(-0.5f * (float)(h + 1));
    float q[64], o[64];
    { const bf16_t* qp = projc + row * ODD_IN + OQ + h * 64;
#pragma unroll
      for (int i = 0; i < 64; ++i) { q[i] = bf2f(qp[i]); o[i] = 0.f; } }
    float m = sinks[h], l = 1.f;
    const int j0 = (qpos - 127 > 0) ? qpos - 127 : 0;
    for (int j = j0; j <= qpos; ++j) {
        const bf16_t* kp = projc + ((size_t)b * SEQ + j) * ODD_IN + OK_ + kvh * 64; float d = 0.f;
#pragma unroll
        for (int i = 0; i < 64; ++i) d += q[i] * bf2f(kp[i]);
        const float a = d * 0.125f - slope * (float)(qpos - j);
        const float n = fmaxf(m, a), c = __expf(m - n), p = __expf(a - n);
        m = n; l = l * c + p;
        const bf16_t* vp = projc + ((size_t)b * SEQ + j) * ODD_IN + OV + kvh * 64;
#pragma unroll
        for (int i = 0; i < 64; ++i) o[i] = o[i] * c + p * bf2f(vp[i]);
    }
    const float il = 1.f / l; const bf16_t* gp = projc + row * ODD_IN + OG_ + h * 64; bf16_t* op = OGb + row * DM + h * 64;
#pragma unroll
    for (int i = 0; i < 64; ++i) op[i] = (bf16_t)f2bf(o[i] * il * silu_f(bf2f(gp[i])));
}

extern "C" void kernel_launch(void* const* d_in, const int* in_sizes, int n_in, void* d_out, int out_size, void* d_ws, size_t ws_size, hipStream_t stream) {
    if (n_in != 21 || in_sizes[0] != MROWS * DM || out_size != MROWS * DM || ws_size < WS_END) { fprintf(stderr, "kernel_launch: unexpected shapes (n_in %d, ws %zu)\n", n_in, ws_size); return; }
    const float* x = (const float*)d_in[0]; const float* norm_a = (const float*)d_in[1]; const float* w_in_a = (const float*)d_in[2];
    const float* conv_w = (const float*)d_in[3]; const float* conv_b = (const float*)d_in[4]; const float* dt_bias = (const float*)d_in[5];
    const float* a_log = (const float*)d_in[6]; const float* d_skip = (const float*)d_in[7]; const float* ssd_norm = (const float*)d_in[8];
    const float* lq1 = (const float*)d_in[9]; const float* lk1 = (const float*)d_in[10]; const float* lq2 = (const float*)d_in[11]; const float* lk2 = (const float*)d_in[12];
    const float* subln = (const float*)d_in[13]; const float* w_out_a = (const float*)d_in[14]; const float* norm_c = (const float*)d_in[15];
    const float* w_in_c = (const float*)d_in[16]; const float* b_in_c = (const float*)d_in[17]; const float* sinks = (const float*)d_in[18];
    const float* w_out_c = (const float*)d_in[19]; const float* final_norm = (const float*)d_in[20];
    unsigned char* ws = (unsigned char*)d_ws; float* out = (float*)d_out;
    bf16_t* WA = (bf16_t*)(ws + WS_WA); bf16_t* WOA = (bf16_t*)(ws + WS_WOA); bf16_t* WC = (bf16_t*)(ws + WS_WC); bf16_t* WOC = (bf16_t*)(ws + WS_WOC);
    float* DT = (float*)(ws + WS_DT); float* SSQ = (float*)(ws + WS_SSQ); float* RSTD0 = (float*)(ws + WS_RSTD0); float* RSTD1 = (float*)(ws + WS_RSTD1);
    bf16_t* PROJ = (bf16_t*)(ws + WS_PROJ); float* X1 = (float*)(ws + WS_X1); bf16_t* XB1 = (bf16_t*)(ws + WS_XB1); bf16_t* PROJC = (bf16_t*)(ws + WS_PROJC); bf16_t* OGb = (bf16_t*)(ws + WS_OG);
    bf16_t* XB = (bf16_t*)d_out; bf16_t* Y = (bf16_t*)d_out;

    k_wt<<<dim3(NA_PAD / 32, DM / 32), 256, 0, stream>>>(w_in_a, norm_a, WA, DM, EVEN_IN, NA_PAD);
    k_wt<<<dim3(DM / 32, 2048 / 32), 256, 0, stream>>>(w_out_a, nullptr, WOA, 2048, DM, DM);
    k_wt<<<dim3(ODD_IN / 32, DM / 32), 256, 0, stream>>>(w_in_c, norm_c, WC, DM, ODD_IN, ODD_IN);
    k_wt<<<dim3(DM / 32, DM / 32), 256, 0, stream>>>(w_out_c, nullptr, WOC, DM, DM, DM);
    k_xprep<<<MROWS / 4, 256, 0, stream>>>(x, XB, RSTD0);
    k_gemm<EpiProjA><<<dim3(NA_PAD / 64, MROWS / 64), 256, 0, stream>>>(XB, WA, DM, EpiProjA{PROJ, DT, RSTD0});
    k_diffattn<<<dim3(SEQ / 64, 8, BATCH), 256, 0, stream>>>(PROJ, lq1, lk1, lq2, lk2, subln, Y);
    k_ssd<<<dim3(16, BATCH), 256, 0, stream>>>(PROJ, DT, conv_w, conv_b, dt_bias, a_log, d_skip, Y, SSQ);
    k_ssdnorm<<<MROWS / 4, 256, 0, stream>>>(Y, SSQ, ssd_norm);
    k_gemm<EpiRes1><<<dim3(DM / 64, MROWS / 64), 256, 0, stream>>>(Y, WOA, 2048, EpiRes1{x, X1, XB1});
    k_rowrstd<<<MROWS / 4, 256, 0, stream>>>(X1, RSTD1);
    k_gemm<EpiProjC><<<dim3(ODD_IN / 64, MROWS / 64), 256, 0, stream>>>(XB1, WC, DM, EpiProjC{PROJC, RSTD1, b_in_c});
    k_swa<<<dim3(SEQ / 256, 16, BATCH), 256, 0, stream>>>(PROJC, sinks, OGb);
    k_gemm<EpiRes1><<<dim3(DM / 64, MROWS / 64), 256, 0, stream>>>(OGb, WOC, DM, EpiRes1{X1, X1, nullptr});
    k_final<<<MROWS / 4, 256, 0, stream>>>(X1, final_norm, out);
}
```

```cpp
#include <hip/hip_runtime.h>
#include <cstdio>
#include <cstdint>
#include <cmath>

typedef unsigned short bf16_t;
typedef unsigned u32x4 __attribute__((ext_vector_type(4)));
typedef float f32x4 __attribute__((ext_vector_type(4)));

constexpr int BATCH = 16, SEQ = 2048, DM = 1024, MROWS = BATCH * SEQ;
constexpr int EVEN_IN = 6672, PROJ_P = 6656, NA_PAD = 6912;
constexpr int CQ = 0, CK = 1024, CV = 2048, CGA = 3072, CZ = 4096, CXS = 5120, CBM = 6144, CCM = 6400, CDT = 6656;
constexpr int ODD_IN = 2304;
constexpr int OQ = 0, OK_ = 1024, OV = 1152, OG_ = 1280;
constexpr float EPS = 1e-5f;
constexpr float LAMBDA_INIT = 0.2f;
constexpr float LOG2E = 1.4426950408889634f;

constexpr size_t MiB = 1u << 20;
constexpr size_t WS_CTL = 0;
constexpr size_t WS_WA = 1 * MiB;
constexpr size_t WS_WOA = 15 * MiB;
constexpr size_t WS_WC = 19 * MiB;
constexpr size_t WS_WOC = 24 * MiB;
constexpr size_t WS_DT = 26 * MiB;
constexpr size_t WS_SSQ = 28 * MiB;
constexpr size_t WS_RSTD0 = 30 * MiB;
constexpr size_t WS_RSTD1 = 30 * MiB + 256 * 1024;
constexpr size_t WS_SSQ1 = WS_DT;
constexpr size_t WS_PROJ = 32 * MiB;
constexpr size_t WS_X1 = 32 * MiB;
constexpr size_t WS_XB1 = 160 * MiB;
constexpr size_t WS_PROJC = 224 * MiB;
constexpr size_t WS_OG = 368 * MiB;
constexpr size_t WS_END = 448 * MiB;

__device__ __forceinline__ unsigned f2bf(float f) { unsigned u = __builtin_bit_cast(unsigned, f); return (u + 0x7fffu + ((u >> 16) & 1u)) >> 16; }
__device__ __forceinline__ float bf2f(unsigned h) { return __builtin_bit_cast(float, h << 16); }
__device__ __forceinline__ unsigned pk2(float lo, float hi) { return f2bf(lo) | (f2bf(hi) << 16); }
__device__ __forceinline__ float silu_f(float v) { return v / (1.f + __expf(-v)); }
__device__ __forceinline__ float wave_sum(float v) {
#pragma unroll
    for (int o = 1; o < 64; o <<= 1) v += __shfl_xor(v, o);
    return v;
}

#define LAS __attribute__((address_space(3)))
__device__ __forceinline__ void slow_diffattn_unit(int unit, int tid, const bf16_t* proj, const float* lq1, const float* lk1, const float* lq2, const float* lk2, const float* subln, bf16_t* Y) {
    const int qb = unit & 15, h = (unit >> 4) & 7, b = unit >> 7, qi = tid >> 2, eq = tid & 3;
    const int qpos = qb * 128 + qi; const size_t row = (size_t)b * SEQ + qpos;
    float s1 = 0.f, s2 = 0.f; for (int i = 0; i < 64; ++i) { s1 += lq1[i] * lk1[i]; s2 += lq2[i] * lk2[i]; }
    const float lam = __expf(s1) - __expf(s2) + LAMBDA_INIT;
    const float slope = exp2f(-(float)(h + 1));
    float q0[16], q1[16];
    { const bf16_t* qp = proj + row * PROJ_P + CQ + h * 128 + eq * 16;
#pragma unroll
      for (int i = 0; i < 16; ++i) { q0[i] = bf2f(qp[i]); q1[i] = bf2f(qp[64 + i]); } }
    float o0[32], o1[32];
#pragma unroll
    for (int i = 0; i < 32; ++i) { o0[i] = 0.f; o1[i] = 0.f; }
    float m0 = -INFINITY, m1 = -INFINITY, l0 = 0.f, l1 = 0.f;
    const int jmax = qb * 128 + 127;
    for (int j = 0; j <= jmax; ++j) {
        const bf16_t* kp = proj + ((size_t)b * SEQ + j) * PROJ_P + CK + h * 128 + eq * 16;
        float d0 = 0.f, d1 = 0.f;
#pragma unroll
        for (int i = 0; i < 16; ++i) { d0 += q0[i] * bf2f(kp[i]); d1 += q1[i] * bf2f(kp[64 + i]); }
        d0 += __shfl_xor(d0, 1); d0 += __shfl_xor(d0, 2); d1 += __shfl_xor(d1, 1); d1 += __shfl_xor(d1, 2);
        if (j <= qpos) {
            const float bias = slope * (float)(qpos - j);
            const float a0 = d0 * 0.125f - bias, a1 = d1 * 0.125f - bias;
            const float n0 = fmaxf(m0, a0), n1 = fmaxf(m1, a1);
            const float c0 = __expf(m0 - n0), c1 = __expf(m1 - n1), p0 = __expf(a0 - n0), p1 = __expf(a1 - n1);
            m0 = n0; m1 = n1; l0 = l0 * c0 + p0; l1 = l1 * c1 + p1;
            const bf16_t* vp = proj + ((size_t)b * SEQ + j) * PROJ_P + CV + h * 128 + eq * 32;
#pragma unroll
            for (int i = 0; i < 32; ++i) { const float v = bf2f(vp[i]); o0[i] = o0[i] * c0 + p0 * v; o1[i] = o1[i] * c1 + p1 * v; }
        }
    }
    const float i0 = 1.f / l0, i1 = lam / l1; float ss = 0.f;
#pragma unroll
    for (int i = 0; i < 32; ++i) { o0[i] = o0[i] * i0 - o1[i] * i1; ss += o0[i] * o0[i]; }
    ss += __shfl_xor(ss, 1); ss += __shfl_xor(ss, 2);
    const float r = (1.f - LAMBDA_INIT) / sqrtf(ss * (1.f / 128.f) + EPS);
    const bf16_t* gp = proj + row * PROJ_P + CGA + h * 128 + eq * 32; bf16_t* yp = Y + row * 2048 + h * 128 + eq * 32;
#pragma unroll
    for (int i = 0; i < 32; ++i) yp[i] = (bf16_t)f2bf(o0[i] * r * subln[eq * 32 + i] * silu_f(bf2f(gp[i])));
}

__device__ __forceinline__ void slow_ssd_pair(int pair, int tid, LAS float* sm, const bf16_t* proj, const float* dtraw, const float* conv_w, const float* conv_b, const float* dt_bias, const float* a_log,
                                              const float* d_skip, bf16_t* Y, float* ssq) {
    const int half = tid >> 8, t = tid & 255, unit = pair * 2 + half, hd = unit & 15, b = unit >> 4, g = hd >> 3, p = t >> 2, nq = t & 3;
    LAS float* sB = sm + half * 272; LAS float* sC = sB + 128; LAS float* sRed = sB + 256;
    const int cbc = (t < 128) ? (1024 + g * 128 + t) : (1024 + 256 + g * 128 + (t - 128));
    const int cx = hd * 64 + p;
    float wbc[4], wx[4];
#pragma unroll
    for (int j = 0; j < 4; ++j) { wbc[j] = conv_w[j * 1536 + cbc]; wx[j] = conv_w[j * 1536 + cx]; }
    const float bbc = conv_b[cbc], bx = conv_b[cx];
    const float A = -__expf(a_log[hd]), dtb = dt_bias[hd], Dk = d_skip[hd];
    float hbc[3] = {0.f, 0.f, 0.f}, hx[3] = {0.f, 0.f, 0.f};
    float st[32];
#pragma unroll
    for (int i = 0; i < 32; ++i) st[i] = 0.f;
    for (int ts = 0; ts < SEQ; ++ts) {
        const size_t row = (size_t)b * SEQ + ts; const bf16_t* pr = proj + row * PROJ_P;
        const float rbc = bf2f(pr[CXS + cbc]);
        const float vbc = silu_f(wbc[0] * hbc[0] + wbc[1] * hbc[1] + wbc[2] * hbc[2] + wbc[3] * rbc + bbc);
        hbc[0] = hbc[1]; hbc[1] = hbc[2]; hbc[2] = rbc;
        if (t < 128) sB[t] = bf2f(f2bf(vbc)); else sC[t - 128] = bf2f(f2bf(vbc));
        const float rx = bf2f(pr[CXS + cx]);
        const float vx = bf2f(f2bf(silu_f(wx[0] * hx[0] + wx[1] * hx[1] + wx[2] * hx[2] + wx[3] * rx + bx)));
        hx[0] = hx[1]; hx[1] = hx[2]; hx[2] = rx;
        const float dr = dtraw[row * 16 + hd] + dtb; const float dt = (dr > 20.f) ? dr : log1pf(__expf(dr));
        const float dec = __expf(dt * A), dtx = dt * vx;
        __syncthreads();
        float y = 0.f;
#pragma unroll
        for (int i = 0; i < 32; ++i) { st[i] = st[i] * dec + dtx * sB[nq * 32 + i]; y += sC[nq * 32 + i] * st[i]; }
        y += __shfl_xor(y, 1); y += __shfl_xor(y, 2);
        const float z = bf2f(pr[CZ + hd * 64 + p]);
        const float yz = (y + Dk * vx) * silu_f(z);
        float q = (nq == 0) ? yz * yz : 0.f; q = wave_sum(q);
        if ((t & 63) == 0) sRed[t >> 6] = q;
        if (nq == 0) Y[row * 2048 + 1024 + hd * 64 + p] = (bf16_t)f2bf(yz);
        __syncthreads();
        if (t == 0) ssq[row * 16 + hd] = sRed[0] + sRed[1] + sRed[2] + sRed[3];
    }
}
__device__ __forceinline__ void slow_swa_unit(int unit, int tid, const bf16_t* projc, const float* sinks, bf16_t* OGb) {
    const int qpos = (unit & 3) * 512 + tid, h = (unit >> 2) & 15, b = unit >> 6, kvh = h >> 3;
    const size_t row = (size_t)b * SEQ + qpos;
    const float slope = exp2f(-0.5f * (float)(h + 1));
    float q[64], o[64];
    { const bf16_t* qp = projc + row * ODD_IN + OQ + h * 64;
#pragma unroll
      for (int i = 0; i < 64; ++i) { q[i] = bf2f(qp[i]); o[i] = 0.f; } }
    float m = sinks[h], l = 1.f;
    const int j0 = (qpos - 127 > 0) ? qpos - 127 : 0;
    for (int j = j0; j <= qpos; ++j) {
        const bf16_t* kp = projc + ((size_t)b * SEQ + j) * ODD_IN + OK_ + kvh * 64; float d = 0.f;
#pragma unroll
        for (int i = 0; i < 64; ++i) d += q[i] * bf2f(kp[i]);
        const float a = d * 0.125f - slope * (float)(qpos - j);
        const float n = fmaxf(m, a), c = __expf(m - n), p = __expf(a - n);
        m = n; l = l * c + p;
        const bf16_t* vp = projc + ((size_t)b * SEQ + j) * ODD_IN + OV + kvh * 64;
#pragma unroll
        for (int i = 0; i < 64; ++i) o[i] = o[i] * c + p * bf2f(vp[i]);
    }
    const float il = 1.f / l; const bf16_t* gp = projc + row * ODD_IN + OG_ + h * 64; bf16_t* op = OGb + row * DM + h * 64;
#pragma unroll
    for (int i = 0; i < 64; ++i) op[i] = (bf16_t)f2bf(o[i] * il * silu_f(bf2f(gp[i])));
}

namespace pg8 {
#define PG8_LAS __attribute__((address_space(3)))
typedef unsigned short bf16_t;
typedef short bf16x8 __attribute__((ext_vector_type(8)));
typedef float f32x4 __attribute__((ext_vector_type(4)));
typedef unsigned u32x4 __attribute__((ext_vector_type(4)));
constexpr int BM = 256, BK = 64, HALF = 128, HTB = HALF * BK * 2  , STAGE_BYTES = 8 * HTB, NXCD = 8, WGM = 8;

__host__ __device__ __forceinline__ int lds_byte(int r, int c) { const int st = (r >> 4) * 2 + (c >> 5), rr = r & 15, cc = c & 31, ob = rr * 64 + cc * 2; return st * 1024 + (ob ^ (((ob >> 9) & 1) << 5)); }
__host__ __device__ __forceinline__ void stage_rc(int b, int& R, int& C) { const int st = b / 1024, sb = b % 1024, swz = sb ^ (((sb >> 9) & 1) << 5); R = (st >> 1) * 16 + swz / 64; C = (st & 1) * 32 + (swz % 64) / 2; }
__host__ __device__ __forceinline__ int perm32(int rho) { const int n = rho >> 4, i = rho & 15; return 8 * (i >> 2) + 4 * n + (i & 3); }

struct Unit { int pm, pn; };
struct Gemm { const bf16_t* A; const bf16_t* Bt; int M, N, K; };

struct StaticOrder {
    int nM, nN, nwg, G, c;
    __host__ __device__ void init(int M, int N, int G_, int c_) { nM = M / BM; nN = N / BM; nwg = nM * nN; G = G_; c = c_; }
    __host__ __device__ bool next(int i, Unit& u) const {
        const long L = (long)i * G + c; if (L >= nwg) return false;
        int wgid = (int)L; { const int q = nwg / NXCD, r = nwg % NXCD, xcd = wgid % NXCD, off = wgid / NXCD; wgid = (xcd < r ? xcd * (q + 1) : r * (q + 1) + (xcd - r) * q) + off; }
        const int nig = WGM * nN, gid = wgid / nig, fm = gid * WGM, gsz = (nM - fm) < WGM ? (nM - fm) : WGM;
        u.pm = fm + ((wgid % nig) % gsz); u.pn = (wgid % nig) / gsz; return true;
    }
    __device__ __forceinline__ void a_ready(const Unit&) const {}
    __device__ __forceinline__ void done(const Unit&) const {}
};


__device__ __forceinline__ unsigned cvt_pk_bf16(float lo, float hi) { unsigned r; asm volatile("v_cvt_pk_bf16_f32 %0, %1, %2" : "=v"(r) : "v"(lo), "v"(hi)); return r; }
struct EpiProjA {
    static constexpr bool PERM = true, AFTER_DRAIN = false;
    bf16_t* proj; float* dt; const float* rstd; int pitch, ntile_bf16;
    __device__ __forceinline__ void operator()(const f32x4 (&acc)[2][2][4][2], const Unit& u, int wr, int wc, int fr, int fq) const {
        const int row0 = u.pm * BM + wr * 64 + fr;
        if (u.pn < ntile_bf16) {
            const int col0 = u.pn * BM + wc * 32 + 8 * fq;
#pragma unroll
            for (int ai = 0; ai < 2; ++ai)
#pragma unroll
                for (int m = 0; m < 4; ++m) { const int row = row0 + ai * HALF + m * 16; const float rs = rstd[row]; bf16_t* rowp = proj + (size_t)row * pitch + col0;
#pragma unroll
                    for (int bj = 0; bj < 2; ++bj) { const f32x4 v0 = acc[ai][bj][m][0] * rs, v1 = acc[ai][bj][m][1] * rs;
                        u32x4 w; w.x = cvt_pk_bf16(v0[0], v0[1]); w.y = cvt_pk_bf16(v0[2], v0[3]); w.z = cvt_pk_bf16(v1[0], v1[1]); w.w = cvt_pk_bf16(v1[2], v1[3]);
                        *(u32x4*)(rowp + bj * HALF) = w; } }
        } else if (wc == 0 && fq < 2) {
#pragma unroll
            for (int ai = 0; ai < 2; ++ai)
#pragma unroll
                for (int m = 0; m < 4; ++m) { const int row = row0 + ai * HALF + m * 16; const float rs = rstd[row]; float* dp = dt + (size_t)row * 16 + 8 * fq;
                    *(f32x4*)dp = acc[ai][0][m][0] * rs; *(f32x4*)(dp + 4) = acc[ai][0][m][1] * rs; }
        }
    }
};
struct EpiRes {
    static constexpr bool PERM = true, AFTER_DRAIN = false;
    const float* xin; float* xout; bf16_t* xb; float* ssq; int ldc;
    __device__ __forceinline__ void operator()(const f32x4 (&acc)[2][2][4][2], const Unit& u, int wr, int wc, int fr, int fq) const {
        const int row0 = u.pm * BM + wr * 64 + fr, col0 = u.pn * BM + wc * 32 + 8 * fq;
#pragma unroll
        for (int ai = 0; ai < 2; ++ai)
#pragma unroll
            for (int m = 0; m < 4; ++m) { const int row = row0 + ai * HALF + m * 16; const size_t off = (size_t)row * ldc + col0; float s = 0.f;
#pragma unroll
                for (int bj = 0; bj < 2; ++bj) { const f32x4 a = *(const f32x4*)(xin + off + bj * HALF), b = *(const f32x4*)(xin + off + bj * HALF + 4);
                    const f32x4 o0 = a + acc[ai][bj][m][0], o1 = b + acc[ai][bj][m][1];
                    *(f32x4*)(xout + off + bj * HALF) = o0; *(f32x4*)(xout + off + bj * HALF + 4) = o1;
                    s += (o0[0] * o0[0] + o0[1] * o0[1]) + (o0[2] * o0[2] + o0[3] * o0[3]) + (o1[0] * o1[0] + o1[1] * o1[1]) + (o1[2] * o1[2] + o1[3] * o1[3]);
                    if (xb) { u32x4 w; w.x = cvt_pk_bf16(o0[0], o0[1]); w.y = cvt_pk_bf16(o0[2], o0[3]); w.z = cvt_pk_bf16(o1[0], o1[1]); w.w = cvt_pk_bf16(o1[2], o1[3]); *(u32x4*)(xb + off + bj * HALF) = w; } }
                if (ssq) { s += __shfl_xor(s, 16); s += __shfl_xor(s, 32); if (fq == 0) ssq[(size_t)row * 16 + u.pn * 4 + wc] = s; }
                if (m & 1) asm volatile("" ::: "memory"); }
    }
};
struct EpiProjC {
    static constexpr bool PERM = true, AFTER_DRAIN = false;
    bf16_t* proj; const float* ssq; const float* bias; int pitch; float inv_n, eps;
    __device__ __forceinline__ void operator()(const f32x4 (&acc)[2][2][4][2], const Unit& u, int wr, int wc, int fr, int fq) const {
        const int row0 = u.pm * BM + wr * 64 + fr, col0 = u.pn * BM + wc * 32 + 8 * fq;
        f32x4 bv[2][2];
#pragma unroll
        for (int bj = 0; bj < 2; ++bj)
#pragma unroll
            for (int n = 0; n < 2; ++n) bv[bj][n] = *(const f32x4*)(bias + col0 + bj * HALF + 4 * n);
#pragma unroll
        for (int ai = 0; ai < 2; ++ai)
#pragma unroll
            for (int m = 0; m < 4; ++m) { const int row = row0 + ai * HALF + m * 16; const f32x4* sp = (const f32x4*)(ssq + (size_t)row * 16);
                const f32x4 p0 = sp[0], p1 = sp[1], p2 = sp[2], p3 = sp[3];
                const float ss = ((p0[0] + p0[1]) + (p0[2] + p0[3])) + ((p1[0] + p1[1]) + (p1[2] + p1[3])) + ((p2[0] + p2[1]) + (p2[2] + p2[3])) + ((p3[0] + p3[1]) + (p3[2] + p3[3]));
                const float rs = 1.0f / sqrtf(ss * inv_n + eps); bf16_t* rowp = proj + (size_t)row * pitch + col0;
#pragma unroll
                for (int bj = 0; bj < 2; ++bj) { const f32x4 v0 = acc[ai][bj][m][0] * rs + bv[bj][0], v1 = acc[ai][bj][m][1] * rs + bv[bj][1];
                    u32x4 w; w.x = cvt_pk_bf16(v0[0], v0[1]); w.y = cvt_pk_bf16(v0[2], v0[3]); w.z = cvt_pk_bf16(v1[0], v1[1]); w.w = cvt_pk_bf16(v1[2], v1[3]);
                    *(u32x4*)(rowp + bj * HALF) = w; }
                if (m & 1) asm volatile("" ::: "memory"); }
    }
};

template <class Epi, class Sched, bool ALIGN_EPI = false, bool SP2 = false>
__device__ __forceinline__ void gemm_phase(PG8_LAS unsigned char* lds, const Gemm g, const Sched& S, const Epi& E) {
    const int tid = threadIdx.x, wid = __builtin_amdgcn_readfirstlane(tid >> 6), lane = tid & 63, wr = wid >> 2, wc = wid & 3, fr = lane & 15, fq = lane >> 4;
    const int K = g.K, nt = K / BK;
    unsigned voffA[2], voffB[2];
#pragma unroll
    for (int i = 0; i < 2; ++i) { int R, C; stage_rc(tid * 16 + i * 8192, R, C); const int Rb = Epi::PERM ? ((R & ~31) + perm32(R & 31)) : R;
        voffA[i] = (unsigned)(R * K + C) * 2u; voffB[i] = (unsigned)(Rb * K + C) * 2u; }
    const size_t kstep = (size_t)(BK * 2);
    const size_t hstep = (size_t)HALF * K * 2;
    const size_t tstep = 2 * hstep;
    const unsigned ldsw = (unsigned)wid * 1024u;
    const int aoff = lds_byte(wr * 64 + fr, fq * 8), boff = lds_byte(wc * 32 + fr, fq * 8);
#define PG8_SA(b, h) (((b) * 2 + (h)) * HTB)
#define PG8_SB(b, h) ((4 + (b) * 2 + (h)) * HTB)
#define PG8_STAGE(bufoff, gbase, voff) do { _Pragma("unroll") for (int _i = 0; _i < 2; ++_i) \
        __builtin_amdgcn_global_load_lds((const unsigned*)((const char*)(gbase) + (voff)[_i]), (PG8_LAS unsigned*)(lds + (bufoff) + ldsw + _i * 8192), 16, 0, 0); } while (0)
#define PG8_LDA(dst, b, h) do { _Pragma("unroll") for (int m = 0; m < 4; ++m) _Pragma("unroll") for (int k = 0; k < 2; ++k) dst[m][k] = *(const PG8_LAS bf16x8*)(lds + PG8_SA(b, h) + aoff + m * 2048 + k * 1024); } while (0)
#define PG8_LDB(dst, b, h) do { _Pragma("unroll") for (int n = 0; n < 2; ++n) _Pragma("unroll") for (int k = 0; k < 2; ++k) dst[n][k] = *(const PG8_LAS bf16x8*)(lds + PG8_SB(b, h) + boff + n * 2048 + k * 1024); } while (0)
#define PG8_MMA(ai, bj, At, Bt) do { __builtin_amdgcn_s_setprio(1); _Pragma("unroll") for (int m = 0; m < 4; ++m) _Pragma("unroll") for (int n = 0; n < 2; ++n) _Pragma("unroll") for (int k = 0; k < 2; ++k) \
        acc[ai][bj][m][n] = __builtin_amdgcn_mfma_f32_16x16x32_bf16(Bt[n][k], At[m][k], acc[ai][bj][m][n], 0, 0, 0); __builtin_amdgcn_s_setprio(0); } while (0)
#define PG8_WAIT_V(n) asm volatile("s_waitcnt vmcnt(" #n ")" ::: "memory")
#define PG8_WAIT_L(n) asm volatile("s_waitcnt lgkmcnt(" #n ")" ::: "memory")
#define PG8_BAR __builtin_amdgcn_s_barrier()
#define PG8_SCHED __builtin_amdgcn_sched_barrier(0)
    Unit cur, nxt; int ui = 0;
    if (!S.next(0, cur)) return;
    f32x4 acc[2][2][4][2];
#pragma unroll
    for (int a = 0; a < 2; ++a)
#pragma unroll
        for (int b = 0; b < 2; ++b)
#pragma unroll
            for (int m = 0; m < 4; ++m)
#pragma unroll
                for (int n = 0; n < 2; ++n) acc[a][b][m][n] = (f32x4){0.f, 0.f, 0.f, 0.f};
    bf16x8 At[4][2], B0[2][2], B1[2][2];
    const char* cA = (const char*)g.A + (size_t)cur.pm * tstep; const char* cB = (const char*)g.Bt + (size_t)cur.pn * tstep;
    S.a_ready(cur);
    if constexpr (SP2) {
        PG8_STAGE(PG8_SB(0, 0), cB, voffB); PG8_STAGE(PG8_SB(0, 1), cB + hstep, voffB); PG8_STAGE(PG8_SA(0, 0), cA, voffA); PG8_STAGE(PG8_SA(0, 1), cA + hstep, voffA);
        if (wr == 1) PG8_BAR;
        PG8_WAIT_V(2); PG8_BAR;
        PG8_STAGE(PG8_SB(1, 0), cB + kstep, voffB); PG8_STAGE(PG8_SA(1, 0), cA + kstep, voffA); PG8_STAGE(PG8_SB(1, 1), cB + hstep + kstep, voffB);
        PG8_WAIT_V(6); PG8_BAR;
    } else {
        PG8_STAGE(PG8_SB(0, 0), cB, voffB); PG8_STAGE(PG8_SA(0, 0), cA, voffA); PG8_STAGE(PG8_SB(0, 1), cB + hstep, voffB); PG8_STAGE(PG8_SA(0, 1), cA + hstep, voffA);
        if (wr == 1) PG8_BAR;
        PG8_WAIT_V(4); PG8_BAR;
        PG8_STAGE(PG8_SB(1, 0), cB + kstep, voffB); PG8_STAGE(PG8_SA(1, 0), cA + kstep, voffA); PG8_STAGE(PG8_SB(1, 1), cB + hstep + kstep, voffB);
        PG8_WAIT_V(6); PG8_BAR;
    }
    for (;;) {
        const bool has_next = S.next(ui + 1, nxt);
        const char* nA = has_next ? (const char*)g.A + (size_t)nxt.pm * tstep : cA; const char* nB = has_next ? (const char*)g.Bt + (size_t)nxt.pn * tstep : cB;
        for (int t = 0; t < nt; t += 2) {
            const bool last = (t == nt - 2);
            const char* a1 = cA + (size_t)(t + 1) * kstep;
            const char* a2 = last ? nA : cA + (size_t)(t + 2) * kstep; const char* b2 = last ? nB : cB + (size_t)(t + 2) * kstep;
            const char* a3 = a2 + kstep; const char* b3 = b2 + kstep;
            if (last && has_next) S.a_ready(nxt);
            if constexpr (SP2) {
            PG8_LDB(B0, 0, 0); PG8_LDB(B1, 0, 1); PG8_SCHED; PG8_LDA(At, 0, 0); PG8_STAGE(PG8_SA(1, 1), a1 + hstep, voffA);
            PG8_WAIT_V(8); PG8_WAIT_L(0); PG8_BAR; PG8_MMA(0, 0, At, B0); PG8_MMA(0, 1, At, B1); PG8_BAR; PG8_SCHED;
            PG8_LDA(At, 0, 1); PG8_STAGE(PG8_SB(0, 0), b2, voffB); PG8_STAGE(PG8_SB(0, 1), b2 + hstep, voffB); PG8_STAGE(PG8_SA(0, 0), a2, voffA);
            PG8_WAIT_V(8); PG8_WAIT_L(0); PG8_BAR; PG8_MMA(1, 0, At, B0); PG8_MMA(1, 1, At, B1); PG8_BAR; PG8_SCHED;
            PG8_LDB(B0, 1, 0); PG8_LDB(B1, 1, 1); PG8_SCHED; PG8_LDA(At, 1, 0); PG8_STAGE(PG8_SA(0, 1), a2 + hstep, voffA);
            PG8_WAIT_V(8); PG8_WAIT_L(0); PG8_BAR; PG8_MMA(0, 0, At, B0); PG8_MMA(0, 1, At, B1); PG8_BAR; PG8_SCHED;
            PG8_LDA(At, 1, 1); PG8_STAGE(PG8_SB(1, 0), b3, voffB); PG8_STAGE(PG8_SB(1, 1), b3 + hstep, voffB); PG8_STAGE(PG8_SA(1, 0), a3, voffA);
            PG8_WAIT_V(8); PG8_WAIT_L(0); PG8_BAR; PG8_MMA(1, 0, At, B0); PG8_MMA(1, 1, At, B1); PG8_BAR; PG8_SCHED;
            } else {
            PG8_LDB(B0, 0, 0); PG8_SCHED; PG8_LDA(At, 0, 0); PG8_STAGE(PG8_SA(1, 1), a1 + hstep, voffA);
            PG8_WAIT_L(8); PG8_BAR; PG8_WAIT_L(0); PG8_MMA(0, 0, At, B0); PG8_BAR; PG8_SCHED;
            PG8_LDB(B1, 0, 1); PG8_STAGE(PG8_SB(0, 0), b2, voffB);
            PG8_BAR; PG8_WAIT_L(0); PG8_MMA(0, 1, At, B1); PG8_BAR;
            PG8_LDA(At, 0, 1); PG8_STAGE(PG8_SA(0, 0), a2, voffA);
            PG8_BAR; PG8_WAIT_L(0); PG8_MMA(1, 0, At, B0); PG8_BAR; PG8_SCHED;
            PG8_STAGE(PG8_SB(0, 1), b2 + hstep, voffB);
            PG8_WAIT_V(6); PG8_BAR; PG8_MMA(1, 1, At, B1); PG8_BAR;
            PG8_LDB(B0, 1, 0); PG8_SCHED; PG8_LDA(At, 1, 0); PG8_STAGE(PG8_SA(0, 1), a2 + hstep, voffA);
            PG8_WAIT_L(8); PG8_BAR; PG8_WAIT_L(0); PG8_MMA(0, 0, At, B0); PG8_BAR; PG8_SCHED;
            PG8_LDB(B1, 1, 1); PG8_STAGE(PG8_SB(1, 0), b3, voffB);
            PG8_BAR; PG8_WAIT_L(0); PG8_MMA(0, 1, At, B1); PG8_BAR;
            PG8_LDA(At, 1, 1); PG8_STAGE(PG8_SA(1, 0), a3, voffA);
            PG8_BAR; PG8_WAIT_L(0); PG8_MMA(1, 0, At, B0); PG8_BAR; PG8_SCHED;
            PG8_STAGE(PG8_SB(1, 1), b3 + hstep, voffB);
            PG8_WAIT_V(6); PG8_BAR; PG8_MMA(1, 1, At, B1); PG8_BAR;
            }
        }
        if constexpr (ALIGN_EPI) { if (wr == 0) PG8_BAR; }
        if constexpr (!Epi::AFTER_DRAIN) { E(acc, cur, wr, wc, fr, fq); S.done(cur); }
        if (!has_next) break;
#pragma unroll
        for (int a = 0; a < 2; ++a)
#pragma unroll
            for (int b = 0; b < 2; ++b)
#pragma unroll
                for (int m = 0; m < 4; ++m)
#pragma unroll
                    for (int n = 0; n < 2; ++n) acc[a][b][m][n] = (f32x4){0.f, 0.f, 0.f, 0.f};
        cur = nxt; cA = nA; cB = nB; ++ui;
        if constexpr (ALIGN_EPI) { if (wr == 1) PG8_BAR; }
    }
    PG8_WAIT_V(0);
    if constexpr (!ALIGN_EPI) { if (wr == 0) PG8_BAR; }
    PG8_BAR;
    if constexpr (Epi::AFTER_DRAIN) { E.fused(acc, cur, wr, wc, fr, fq, lds, wid, lane); S.done(cur); }
#undef PG8_SA
#undef PG8_SB
#undef PG8_STAGE
#undef PG8_LDA
#undef PG8_LDB
#undef PG8_MMA
#undef PG8_WAIT_V
#undef PG8_WAIT_L
#undef PG8_BAR
#undef PG8_SCHED
}
}

#include <hip/hip_cooperative_groups.h>
namespace cg = cooperative_groups;
#define GAS __attribute__((address_space(1)))
#define LDS_WAIT() asm volatile("s_waitcnt lgkmcnt(0)" ::: "memory")
constexpr int NWAVES = 8, NTHREADS = NWAVES * 64;
constexpr int RING_BYTES = 131072, LDS_BYTES = 147456;
constexpr int NPHASE = 9;

struct Args { const float* in[21]; float* out; unsigned char* ws; int ph_lo, ph_hi; };

__device__ __forceinline__ void p0_transpose_item(const float* W, const float* s, int K, int N, bf16_t* WT, LAS float* scr, int item, int nblk, int lane) {
    const int kb = item / nblk, nb = item % nblk, k0 = 64 * kb, n0 = 32 * nb, n = n0 + (lane & 31);
    const bool ok = n < N;
#pragma unroll 8
    for (int i = 0; i < 32; ++i) { const int kk = 2 * i + (lane >> 5); float v = ok ? W[(size_t)(k0 + kk) * N + n] : 0.f; if (s) v *= s[k0 + kk]; scr[kk * 33 + (lane & 31)] = v; }
    LDS_WAIT(); asm volatile("" ::: "memory");
    const int c = lane & 7;
#pragma unroll
    for (int j = 0; j < 4; ++j) { const int nn = (lane >> 3) + 8 * j; const LAS float* sp = scr + (8 * c) * 33 + nn;
        u32x4 o; o.x = pk2(sp[0 * 33], sp[1 * 33]); o.y = pk2(sp[2 * 33], sp[3 * 33]); o.z = pk2(sp[4 * 33], sp[5 * 33]); o.w = pk2(sp[6 * 33], sp[7 * 33]);
        *(u32x4*)(WT + (size_t)(n0 + nn) * K + k0 + 8 * c) = o; }
    LDS_WAIT(); asm volatile("" ::: "memory");
}

__global__ void __launch_bounds__(NTHREADS, 2) mega(Args a) {
    extern __shared__ __attribute__((aligned(16))) unsigned char lds[];
    cg::grid_group grid = cg::this_grid();
    const int tid = threadIdx.x, lane = tid & 63, wave = __builtin_amdgcn_readfirstlane(tid >> 6);
    const int G = gridDim.x, bx = blockIdx.x, vcu = (G % 8 == 0) ? (bx % 8) * (G / 8) + bx / 8 : bx;
    const int gw = vcu * NWAVES + wave, NGW = G * NWAVES;
    unsigned char* ws = a.ws;
    const float* x = a.in[0];
    bf16_t* WA = (bf16_t*)(ws + WS_WA); bf16_t* WOA = (bf16_t*)(ws + WS_WOA); bf16_t* WC = (bf16_t*)(ws + WS_WC); bf16_t* WOC = (bf16_t*)(ws + WS_WOC);
    float* DT = (float*)(ws + WS_DT); float* SSQ = (float*)(ws + WS_SSQ); float* RSTD0 = (float*)(ws + WS_RSTD0); float* SSQ1 = (float*)(ws + WS_SSQ1);
    bf16_t* PROJ = (bf16_t*)(ws + WS_PROJ); float* X1 = (float*)(ws + WS_X1); bf16_t* XB1 = (bf16_t*)(ws + WS_XB1); bf16_t* PROJC = (bf16_t*)(ws + WS_PROJC); bf16_t* OGb = (bf16_t*)(ws + WS_OG);
    bf16_t* XB = (bf16_t*)a.out; bf16_t* Y = (bf16_t*)a.out;
    const int lo = a.ph_lo, hi = a.ph_hi;
#define IN(k) (lo <= (k) && (k) < hi)
#define SEAM(k) do { if (IN(k) && IN((k) + 1)) grid.sync(); } while (0)

    if (IN(0)) {
        LAS float* scr = (LAS float*)((LAS unsigned char*)lds + wave * 16384);
        constexpr int I_A = (DM / 64) * (NA_PAD / 32), I_OA = (2048 / 64) * (DM / 32), I_C = (DM / 64) * (ODD_IN / 32), I_OC = (DM / 64) * (DM / 32);
        for (int it = gw; it < I_A + I_OA + I_C + I_OC; it += NGW) {
            int r = it;
            if (r < I_A) { p0_transpose_item(a.in[2], a.in[1], DM, EVEN_IN, WA, scr, r, NA_PAD / 32, lane); continue; } r -= I_A;
            if (r < I_OA) { p0_transpose_item(a.in[14], nullptr, 2048, DM, WOA, scr, r, DM / 32, lane); continue; } r -= I_OA;
            if (r < I_C) { p0_transpose_item(a.in[16], a.in[15], DM, ODD_IN, WC, scr, r, ODD_IN / 32, lane); continue; } r -= I_C;
            p0_transpose_item(a.in[19], nullptr, DM, DM, WOC, scr, r, DM / 32, lane);
        }
        for (int m = gw; m < MROWS; m += NGW) {
            const f32x4* xr = (const f32x4*)(x + (size_t)m * DM) + lane; float s = 0.f;
            unsigned long long* o8 = (unsigned long long*)(XB + (size_t)m * DM) + lane;
#pragma unroll
            for (int j = 0; j < 4; ++j) { const f32x4 v = xr[64 * j]; s += (v.x * v.x + v.y * v.y) + (v.z * v.z + v.w * v.w); o8[64 * j] = (unsigned long long)pk2(v.x, v.y) | ((unsigned long long)pk2(v.z, v.w) << 32); }
            s = wave_sum(s);
            if (lane == 0) RSTD0[m] = 1.f / sqrtf(s * (1.f / DM) + EPS);
        }
    }
    SEAM(0);
    if (IN(1)) {
        pg8::Gemm g{XB, WA, MROWS, NA_PAD, DM}; pg8::StaticOrder S; S.init(MROWS, NA_PAD, G, bx);
        pg8::EpiProjA E{PROJ, DT, RSTD0, PROJ_P, PROJ_P / 256};
        pg8::gemm_phase<pg8::EpiProjA, pg8::StaticOrder, true, true>((LAS unsigned char*)lds, g, S, E);
    }
    SEAM(1);
    if (IN(2)) {
        for (int u = bx; u < 2048; u += G) slow_diffattn_unit(u, tid, PROJ, a.in[9], a.in[10], a.in[11], a.in[12], a.in[13], Y);
        for (int pr = bx; pr < 128; pr += G) slow_ssd_pair(pr, tid, (LAS float*)lds, PROJ, DT, a.in[3], a.in[4], a.in[5], a.in[6], a.in[7], Y, SSQ);
    }
    SEAM(2);
    if (IN(3)) {
        const float* w = a.in[8];
        for (int m = gw; m < MROWS; m += NGW) {
            const float* sq = SSQ + (size_t)m * 16;
#pragma unroll
            for (int g = 0; g < 2; ++g) {
                float s = 0.f;
#pragma unroll
                for (int i = 0; i < 8; ++i) s += sq[g * 8 + i];
                const float r = 1.f / sqrtf(s * (1.f / 512.f) + EPS);
                u32x4* yp = (u32x4*)(Y + (size_t)m * 2048 + 1024 + g * 512) + lane; const float* wp = w + g * 512 + lane * 8;
                u32x4 v = *yp;
#pragma unroll
                for (int i = 0; i < 4; ++i) v[i] = pk2(bf2f(v[i] & 0xffffu) * r * wp[2 * i], bf2f(v[i] >> 16) * r * wp[2 * i + 1]);
                *yp = v;
            }
        }
    }
    SEAM(3);
    if (IN(4)) {
        pg8::Gemm g{Y, WOA, MROWS, DM, 2048}; pg8::StaticOrder S; S.init(MROWS, DM, G, bx);
        pg8::EpiRes E{x, X1, XB1, SSQ1, DM};
        pg8::gemm_phase<pg8::EpiRes, pg8::StaticOrder, true, true>((LAS unsigned char*)lds, g, S, E);
    }
    SEAM(4);
    if (IN(5)) {
        pg8::Gemm g{XB1, WC, MROWS, ODD_IN, DM}; pg8::StaticOrder S; S.init(MROWS, ODD_IN, G, bx);
        pg8::EpiProjC E{PROJC, SSQ1, a.in[17], ODD_IN, 1.f / DM, EPS};
        pg8::gemm_phase<pg8::EpiProjC, pg8::StaticOrder, true, true>((LAS unsigned char*)lds, g, S, E);
    }
    SEAM(5);
    if (IN(6)) {
        for (int u = bx; u < 1024; u += G) slow_swa_unit(u, tid, PROJC, a.in[18], OGb);
    }
    SEAM(6);
    if (IN(7)) {
        pg8::Gemm g{OGb, WOC, MROWS, DM, DM}; pg8::StaticOrder S; S.init(MROWS, DM, G, bx);
        pg8::EpiRes E{X1, X1, nullptr, nullptr, DM};
        pg8::gemm_phase<pg8::EpiRes, pg8::StaticOrder, true, true>((LAS unsigned char*)lds, g, S, E);
    }
    SEAM(7);
    if (IN(8)) {
        const f32x4* wr = (const f32x4*)a.in[20] + lane;
        for (int m = gw; m < MROWS; m += NGW) {
            const f32x4* xr = (const f32x4*)(X1 + (size_t)m * DM) + lane; f32x4 v[4]; float s = 0.f;
#pragma unroll
            for (int j = 0; j < 4; ++j) { v[j] = xr[64 * j]; s += (v[j].x * v[j].x + v[j].y * v[j].y) + (v[j].z * v[j].z + v[j].w * v[j].w); }
            s = wave_sum(s); const float r = 1.f / sqrtf(s * (1.f / DM) + EPS);
            f32x4* o = (f32x4*)(a.out + (size_t)m * DM) + lane;
#pragma unroll
            for (int j = 0; j < 4; ++j) o[64 * j] = v[j] * r * wr[64 * j];
        }
    }
#undef IN
#undef SEAM
}

static int g_grid = 0;
static void launch_mega(const Args& base, int lo, int hi, hipStream_t stream) {
    Args a = base; a.ph_lo = lo; a.ph_hi = hi; void* params[] = {&a};
    hipError_t e = hipLaunchCooperativeKernel((const void*)mega, dim3(g_grid), dim3(NTHREADS), params, LDS_BYTES, stream);
    if (e != hipSuccess) fprintf(stderr, "kernel_launch: cooperative launch [%d,%d) failed: %s (grid %d)\n", lo, hi, hipGetErrorString(e), g_grid);
}
extern "C" void kernel_launch(void* const* d_in, const int* in_sizes, int n_in, void* d_out, int out_size, void* d_ws, size_t ws_size, hipStream_t stream) {
    if (n_in != 21 || in_sizes[0] != MROWS * DM || out_size != MROWS * DM || ws_size < WS_END) { fprintf(stderr, "kernel_launch: unexpected shapes (n_in %d, ws %zu)\n", n_in, ws_size); return; }
    if (g_grid == 0) {
        int dev = 0, cus = 0, per_cu = 0;
        (void)hipGetDevice(&dev); (void)hipDeviceGetAttribute(&cus, hipDeviceAttributeMultiprocessorCount, dev);
        if (hipFuncSetAttribute((const void*)mega, hipFuncAttributeMaxDynamicSharedMemorySize, LDS_BYTES) != hipSuccess) { fprintf(stderr, "kernel_launch: hipFuncSetAttribute failed\n"); g_grid = -1; return; }
        if (hipOccupancyMaxActiveBlocksPerMultiprocessor(&per_cu, (const void*)mega, NTHREADS, LDS_BYTES) != hipSuccess || per_cu < 1) { fprintf(stderr, "kernel_launch: occupancy query says %d blocks per CU\n", per_cu); g_grid = -1; return; }
        g_grid = cus;
        fprintf(stderr, "kernel_launch: %d CUs, %d blocks/CU admitted, grid %d\n", cus, per_cu, g_grid);
    }
    if (g_grid < 0) return;
    unsigned char* ws = (unsigned char*)d_ws;
    Args a{}; for (int i = 0; i < 21; ++i) a.in[i] = (const float*)d_in[i];
    a.out = (float*)d_out; a.ws = ws;
    launch_mega(a, 0, NPHASE, stream);
}
```

```cpp
#include <hip/hip_runtime.h>
#include <cstdio>
#include <cstdint>
#include <cmath>

typedef unsigned short bf16_t;
typedef unsigned u32x4 __attribute__((ext_vector_type(4)));
typedef float f32x4 __attribute__((ext_vector_type(4)));

constexpr int BATCH = 16, SEQ = 2048, DM = 1024, MROWS = BATCH * SEQ;
constexpr int EVEN_IN = 6672, PROJ_P = 6656, NA_PAD = 6912;
constexpr int CQ = 0, CK = 1024, CV = 2048, CGA = 3072, CZ = 4096, CXS = 5120, CBM = 6144, CCM = 6400, CDT = 6656;
constexpr int ODD_IN = 2304;
constexpr int OQ = 0, OK_ = 1024, OV = 1152, OG_ = 1280;
constexpr float EPS = 1e-5f;
constexpr float LAMBDA_INIT = 0.2f;
constexpr float LOG2E = 1.4426950408889634f;

constexpr size_t MiB = 1u << 20;
constexpr size_t WS_CTL = 0;
constexpr size_t WS_WA = 1 * MiB;
constexpr size_t WS_WOA = 15 * MiB;
constexpr size_t WS_WC = 19 * MiB;
constexpr size_t WS_WOC = 24 * MiB;
constexpr size_t WS_DT = 26 * MiB;
constexpr size_t WS_SSQ = 28 * MiB;
constexpr size_t WS_RSTD0 = 30 * MiB;
constexpr size_t WS_RSTD1 = 30 * MiB + 256 * 1024;
constexpr size_t WS_SSQ1 = WS_DT;
constexpr size_t WS_PROJ = 32 * MiB;
constexpr size_t WS_X1 = 32 * MiB;
constexpr size_t WS_XB1 = 160 * MiB;
constexpr size_t WS_PROJC = 224 * MiB;
constexpr size_t WS_OG = 368 * MiB;
constexpr size_t WS_END = 448 * MiB;

__device__ __forceinline__ unsigned f2bf(float f) { unsigned u = __builtin_bit_cast(unsigned, f); return (u + 0x7fffu + ((u >> 16) & 1u)) >> 16; }
__device__ __forceinline__ float bf2f(unsigned h) { return __builtin_bit_cast(float, h << 16); }
__device__ __forceinline__ unsigned pk2(float lo, float hi) { return f2bf(lo) | (f2bf(hi) << 16); }
__device__ __forceinline__ float silu_f(float v) { return v / (1.f + __expf(-v)); }
__device__ __forceinline__ float wave_sum(float v) {
#pragma unroll
    for (int o = 1; o < 64; o <<= 1) v += __shfl_xor(v, o);
    return v;
}

#define LAS __attribute__((address_space(3)))
__device__ __forceinline__ void slow_diffattn_unit(int unit, int tid, const bf16_t* proj, const float* lq1, const float* lk1, const float* lq2, const float* lk2, const float* subln, bf16_t* Y) {
    const int qb = unit & 15, h = (unit >> 4) & 7, b = unit >> 7, qi = tid >> 2, eq = tid & 3;
    const int qpos = qb * 128 + qi; const size_t row = (size_t)b * SEQ + qpos;
    float s1 = 0.f, s2 = 0.f; for (int i = 0; i < 64; ++i) { s1 += lq1[i] * lk1[i]; s2 += lq2[i] * lk2[i]; }
    const float lam = __expf(s1) - __expf(s2) + LAMBDA_INIT;
    const float slope = exp2f(-(float)(h + 1));
    float q0[16], q1[16];
    { const bf16_t* qp = proj + row * PROJ_P + CQ + h * 128 + eq * 16;
#pragma unroll
      for (int i = 0; i < 16; ++i) { q0[i] = bf2f(qp[i]); q1[i] = bf2f(qp[64 + i]); } }
    float o0[32], o1[32];
#pragma unroll
    for (int i = 0; i < 32; ++i) { o0[i] = 0.f; o1[i] = 0.f; }
    float m0 = -INFINITY, m1 = -INFINITY, l0 = 0.f, l1 = 0.f;
    const int jmax = qb * 128 + 127;
    for (int j = 0; j <= jmax; ++j) {
        const bf16_t* kp = proj + ((size_t)b * SEQ + j) * PROJ_P + CK + h * 128 + eq * 16;
        float d0 = 0.f, d1 = 0.f;
#pragma unroll
        for (int i = 0; i < 16; ++i) { d0 += q0[i] * bf2f(kp[i]); d1 += q1[i] * bf2f(kp[64 + i]); }
        d0 += __shfl_xor(d0, 1); d0 += __shfl_xor(d0, 2); d1 += __shfl_xor(d1, 1); d1 += __shfl_xor(d1, 2);
        if (j <= qpos) {
            const float bias = slope * (float)(qpos - j);
            const float a0 = d0 * 0.125f - bias, a1 = d1 * 0.125f - bias;
            const float n0 = fmaxf(m0, a0), n1 = fmaxf(m1, a1);
            const float c0 = __expf(m0 - n0), c1 = __expf(m1 - n1), p0 = __expf(a0 - n0), p1 = __expf(a1 - n1);
            m0 = n0; m1 = n1; l0 = l0 * c0 + p0; l1 = l1 * c1 + p1;
            const bf16_t* vp = proj + ((size_t)b * SEQ + j) * PROJ_P + CV + h * 128 + eq * 32;
#pragma unroll
            for (int i = 0; i < 32; ++i) { const float v = bf2f(vp[i]); o0[i] = o0[i] * c0 + p0 * v; o1[i] = o1[i] * c1 + p1 * v; }
        }
    }
    const float i0 = 1.f / l0, i1 = lam / l1; float ss = 0.f;
#pragma unroll
    for (int i = 0; i < 32; ++i) { o0[i] = o0[i] * i0 - o1[i] * i1; ss += o0[i] * o0[i]; }
    ss += __shfl_xor(ss, 1); ss += __shfl_xor(ss, 2);
    const float r = (1.f - LAMBDA_INIT) / sqrtf(ss * (1.f / 128.f) + EPS);
    const bf16_t* gp = proj + row * PROJ_P + CGA + h * 128 + eq * 32; bf16_t* yp = Y + row * 2048 + h * 128 + eq * 32;
#pragma unroll
    for (int i = 0; i < 32; ++i) yp[i] = (bf16_t)f2bf(o0[i] * r * subln[eq * 32 + i] * silu_f(bf2f(gp[i])));
}

__device__ __forceinline__ void slow_ssd_pair(int pair, int tid, LAS float* sm, const bf16_t* proj, const float* dtraw, const float* conv_w, const float* conv_b, const float* dt_bias, const float* a_log,
                                              const float* d_skip, bf16_t* Y, float* ssq) {
    const int half = tid >> 8, t = tid & 255, unit = pair * 2 + half, hd = unit & 15, b = unit >> 4, g = hd >> 3, p = t >> 2, nq = t & 3;
    LAS float* sB = sm + half * 272; LAS float* sC = sB + 128; LAS float* sRed = sB + 256;
    const int cbc = (t < 128) ? (1024 + g * 128 + t) : (1024 + 256 + g * 128 + (t - 128));
    const int cx = hd * 64 + p;
    float wbc[4], wx[4];
#pragma unroll
    for (int j = 0; j < 4; ++j) { wbc[j] = conv_w[j * 1536 + cbc]; wx[j] = conv_w[j * 1536 + cx]; }
    const float bbc = conv_b[cbc], bx = conv_b[cx];
    const float A = -__expf(a_log[hd]), dtb = dt_bias[hd], Dk = d_skip[hd];
    float hbc[3] = {0.f, 0.f, 0.f}, hx[3] = {0.f, 0.f, 0.f};
    float st[32];
#pragma unroll
    for (int i = 0; i < 32; ++i) st[i] = 0.f;
    for (int ts = 0; ts < SEQ; ++ts) {
        const size_t row = (size_t)b * SEQ + ts; const bf16_t* pr = proj + row * PROJ_P;
        const float rbc = bf2f(pr[CXS + cbc]);
        const float vbc = silu_f(wbc[0] * hbc[0] + wbc[1] * hbc[1] + wbc[2] * hbc[2] + wbc[3] * rbc + bbc);
        hbc[0] = hbc[1]; hbc[1] = hbc[2]; hbc[2] = rbc;
        if (t < 128) sB[t] = bf2f(f2bf(vbc)); else sC[t - 128] = bf2f(f2bf(vbc));
        const float rx = bf2f(pr[CXS + cx]);
        const float vx = bf2f(f2bf(silu_f(wx[0] * hx[0] + wx[1] * hx[1] + wx[2] * hx[2] + wx[3] * rx + bx)));
        hx[0] = hx[1]; hx[1] = hx[2]; hx[2] = rx;
        const float dr = dtraw[row * 16 + hd] + dtb; const float dt = (dr > 20.f) ? dr : log1pf(__expf(dr));
        const float dec = __expf(dt * A), dtx = dt * vx;
        __syncthreads();
        float y = 0.f;
#pragma unroll
        for (int i = 0; i < 32; ++i) { st[i] = st[i] * dec + dtx * sB[nq * 32 + i]; y += sC[nq * 32 + i] * st[i]; }
        y += __shfl_xor(y, 1); y += __shfl_xor(y, 2);
        const float z = bf2f(pr[CZ + hd * 64 + p]);
        const float yz = (y + Dk * vx) * silu_f(z);
        float q = (nq == 0) ? yz * yz : 0.f; q = wave_sum(q);
        if ((t & 63) == 0) sRed[t >> 6] = q;
        if (nq == 0) Y[row * 2048 + 1024 + hd * 64 + p] = (bf16_t)f2bf(yz);
        __syncthreads();
        if (t == 0) ssq[row * 16 + hd] = sRed[0] + sRed[1] + sRed[2] + sRed[3];
    }
}
__device__ __forceinline__ void slow_swa_unit(int unit, int tid, const bf16_t* projc, const float* sinks, bf16_t* OGb) {
    const int qpos = (unit & 3) * 512 + tid, h = (unit >> 2) & 15, b = unit >> 6, kvh = h >> 3;
    const size_t row = (size_t)b * SEQ + qpos;
    const float slope = exp2f(-0.5f * (float)(h + 1));
    float q[64], o[64];
    { const bf16_t* qp = projc + row * ODD_IN + OQ + h * 64;
#pragma unroll
      for (int i = 0; i < 64; ++i) { q[i] = bf2f(qp[i]); o[i] = 0.f; } }
    float m = sinks[h], l = 1.f;
    const int j0 = (qpos - 127 > 0) ? qpos - 127 : 0;
    for (int j = j0; j <= qpos; ++j) {
        const bf16_t* kp = projc + ((size_t)b * SEQ + j) * ODD_IN + OK_ + kvh * 64; float d = 0.f;
#pragma unroll
        for (int i = 0; i < 64; ++i) d += q[i] * bf2f(kp[i]);
        const float a = d * 0.125f - slope * (float)(qpos - j);
        const float n = fmaxf(m, a), c = __expf(m - n), p = __expf(a - n);
        m = n; l = l * c + p;
        const bf16_t* vp = projc + ((size_t)b * SEQ + j) * ODD_IN + OV + kvh * 64;
#pragma unroll
        for (int i = 0; i < 64; ++i) o[i] = o[i] * c + p * bf2f(vp[i]);
    }
    const float il = 1.f / l; const bf16_t* gp = projc + row * ODD_IN + OG_ + h * 64; bf16_t* op = OGb + row * DM + h * 64;
#pragma unroll
    for (int i = 0; i < 64; ++i) op[i] = (bf16_t)f2bf(o[i] * il * silu_f(bf2f(gp[i])));
}

namespace pg8 {
#define PG8_LAS __attribute__((address_space(3)))
typedef unsigned short bf16_t;
typedef short bf16x8 __attribute__((ext_vector_type(8)));
typedef float f32x4 __attribute__((ext_vector_type(4)));
typedef unsigned u32x4 __attribute__((ext_vector_type(4)));
constexpr int BM = 256, BK = 64, HALF = 128, HTB = HALF * BK * 2  , STAGE_BYTES = 8 * HTB, NXCD = 8, WGM = 8;

__host__ __device__ __forceinline__ int lds_byte(int r, int c) { const int st = (r >> 4) * 2 + (c >> 5), rr = r & 15, cc = c & 31, ob = rr * 64 + cc * 2; return st * 1024 + (ob ^ (((ob >> 9) & 1) << 5)); }
__host__ __device__ __forceinline__ void stage_rc(int b, int& R, int& C) { const int st = b / 1024, sb = b % 1024, swz = sb ^ (((sb >> 9) & 1) << 5); R = (st >> 1) * 16 + swz / 64; C = (st & 1) * 32 + (swz % 64) / 2; }
__host__ __device__ __forceinline__ int perm32(int rho) { const int n = rho >> 4, i = rho & 15; return 8 * (i >> 2) + 4 * n + (i & 3); }

struct Unit { int pm, pn; };
struct Gemm { const bf16_t* A; const bf16_t* Bt; int M, N, K; };

struct StaticOrder {
    int nM, nN, nwg, G, c;
    __host__ __device__ void init(int M, int N, int G_, int c_) { nM = M / BM; nN = N / BM; nwg = nM * nN; G = G_; c = c_; }
    __host__ __device__ bool next(int i, Unit& u) const {
        const long L = (long)i * G + c; if (L >= nwg) return false;
        int wgid = (int)L; { const int q = nwg / NXCD, r = nwg % NXCD, xcd = wgid % NXCD, off = wgid / NXCD; wgid = (xcd < r ? xcd * (q + 1) : r * (q + 1) + (xcd - r) * q) + off; }
        const int nig = WGM * nN, gid = wgid / nig, fm = gid * WGM, gsz = (nM - fm) < WGM ? (nM - fm) : WGM;
        u.pm = fm + ((wgid % nig) % gsz); u.pn = (wgid % nig) / gsz; return true;
    }
    __device__ __forceinline__ void a_ready(const Unit&) const {}
    __device__ __forceinline__ void done(const Unit&) const {}
};


__device__ __forceinline__ unsigned cvt_pk_bf16(float lo, float hi) { unsigned r; asm volatile("v_cvt_pk_bf16_f32 %0, %1, %2" : "=v"(r) : "v"(lo), "v"(hi)); return r; }
struct EpiProjA {
    static constexpr bool PERM = true, AFTER_DRAIN = false;
    bf16_t* proj; float* dt; const float* rstd; int pitch, ntile_bf16;
    __device__ __forceinline__ void operator()(const f32x4 (&acc)[2][2][4][2], const Unit& u, int wr, int wc, int fr, int fq) const {
        const int row0 = u.pm * BM + wr * 64 + fr;
        if (u.pn < ntile_bf16) {
            const int col0 = u.pn * BM + wc * 32 + 8 * fq;
#pragma unroll
            for (int ai = 0; ai < 2; ++ai)
#pragma unroll
                for (int m = 0; m < 4; ++m) { const int row = row0 + ai * HALF + m * 16; const float rs = rstd[row]; bf16_t* rowp = proj + (size_t)row * pitch + col0;
#pragma unroll
                    for (int bj = 0; bj < 2; ++bj) { const f32x4 v0 = acc[ai][bj][m][0] * rs, v1 = acc[ai][bj][m][1] * rs;
                        u32x4 w; w.x = cvt_pk_bf16(v0[0], v0[1]); w.y = cvt_pk_bf16(v0[2], v0[3]); w.z = cvt_pk_bf16(v1[0], v1[1]); w.w = cvt_pk_bf16(v1[2], v1[3]);
                        *(u32x4*)(rowp + bj * HALF) = w; } }
        } else if (wc == 0 && fq < 2) {
#pragma unroll
            for (int ai = 0; ai < 2; ++ai)
#pragma unroll
                for (int m = 0; m < 4; ++m) { const int row = row0 + ai * HALF + m * 16; const float rs = rstd[row]; float* dp = dt + (size_t)row * 16 + 8 * fq;
                    *(f32x4*)dp = acc[ai][0][m][0] * rs; *(f32x4*)(dp + 4) = acc[ai][0][m][1] * rs; }
        }
    }
};
struct EpiRes {
    static constexpr bool PERM = true, AFTER_DRAIN = false;
    const float* xin; float* xout; bf16_t* xb; float* ssq; int ldc;
    __device__ __forceinline__ void operator()(const f32x4 (&acc)[2][2][4][2], const Unit& u, int wr, int wc, int fr, int fq) const {
        const int row0 = u.pm * BM + wr * 64 + fr, col0 = u.pn * BM + wc * 32 + 8 * fq;
#pragma unroll
        for (int ai = 0; ai < 2; ++ai)
#pragma unroll
            for (int m = 0; m < 4; ++m) { const int row = row0 + ai * HALF + m * 16; const size_t off = (size_t)row * ldc + col0; float s = 0.f;
#pragma unroll
                for (int bj = 0; bj < 2; ++bj) { const f32x4 a = *(const f32x4*)(xin + off + bj * HALF), b = *(const f32x4*)(xin + off + bj * HALF + 4);
                    const f32x4 o0 = a + acc[ai][bj][m][0], o1 = b + acc[ai][bj][m][1];
                    *(f32x4*)(xout + off + bj * HALF) = o0; *(f32x4*)(xout + off + bj * HALF + 4) = o1;
                    s += (o0[0] * o0[0] + o0[1] * o0[1]) + (o0[2] * o0[2] + o0[3] * o0[3]) + (o1[0] * o1[0] + o1[1] * o1[1]) + (o1[2] * o1[2] + o1[3] * o1[3]);
                    if (xb) { u32x4 w; w.x = cvt_pk_bf16(o0[0], o0[1]); w.y = cvt_pk_bf16(o0[2], o0[3]); w.z = cvt_pk_bf16(o1[0], o1[1]); w.w = cvt_pk_bf16(o1[2], o1[3]); *(u32x4*)(xb + off + bj * HALF) = w; } }
                if (ssq) { s += __shfl_xor(s, 16); s += __shfl_xor(s, 32); if (fq == 0) ssq[(size_t)row * 16 + u.pn * 4 + wc] = s; }
                if (m & 1) asm volatile("" ::: "memory"); }
    }
};
struct EpiProjC {
    static constexpr bool PERM = true, AFTER_DRAIN = false;
    bf16_t* proj; const float* ssq; const float* bias; int pitch; float inv_n, eps;
    __device__ __forceinline__ void operator()(const f32x4 (&acc)[2][2][4][2], const Unit& u, int wr, int wc, int fr, int fq) const {
        const int row0 = u.pm * BM + wr * 64 + fr, col0 = u.pn * BM + wc * 32 + 8 * fq;
        f32x4 bv[2][2];
#pragma unroll
        for (int bj = 0; bj < 2; ++bj)
#pragma unroll
            for (int n = 0; n < 2; ++n) bv[bj][n] = *(const f32x4*)(bias + col0 + bj * HALF + 4 * n);
#pragma unroll
        for (int ai = 0; ai < 2; ++ai)
#pragma unroll
            for (int m = 0; m < 4; ++m) { const int row = row0 + ai * HALF + m * 16; const f32x4* sp = (const f32x4*)(ssq + (size_t)row * 16);
                const f32x4 p0 = sp[0], p1 = sp[1], p2 = sp[2], p3 = sp[3];
                const float ss = ((p0[0] + p0[1]) + (p0[2] + p0[3])) + ((p1[0] + p1[1]) + (p1[2] + p1[3])) + ((p2[0] + p2[1]) + (p2[2] + p2[3])) + ((p3[0] + p3[1]) + (p3[2] + p3[3]));
                const float rs = 1.0f / sqrtf(ss * inv_n + eps); bf16_t* rowp = proj + (size_t)row * pitch + col0;
#pragma unroll
                for (int bj = 0; bj < 2; ++bj) { const f32x4 v0 = acc[ai][bj][m][0] * rs + bv[bj][0], v1 = acc[ai][bj][m][1] * rs + bv[bj][1];
                    u32x4 w; w.x = cvt_pk_bf16(v0[0], v0[1]); w.y = cvt_pk_bf16(v0[2], v0[3]); w.z = cvt_pk_bf16(v1[0], v1[1]); w.w = cvt_pk_bf16(v1[2], v1[3]);
                    *(u32x4*)(rowp + bj * HALF) = w; }
                if (m & 1) asm volatile("" ::: "memory"); }
    }
};

template <class Epi, class Sched, bool ALIGN_EPI = false, bool SP2 = false>
__device__ __forceinline__ void gemm_phase(PG8_LAS unsigned char* lds, const Gemm g, const Sched& S, const Epi& E) {
    const int tid = threadIdx.x, wid = __builtin_amdgcn_readfirstlane(tid >> 6), lane = tid & 63, wr = wid >> 2, wc = wid & 3, fr = lane & 15, fq = lane >> 4;
    const int K = g.K, nt = K / BK;
    unsigned voffA[2], voffB[2];
#pragma unroll
    for (int i = 0; i < 2; ++i) { int R, C; stage_rc(tid * 16 + i * 8192, R, C); const int Rb = Epi::PERM ? ((R & ~31) + perm32(R & 31)) : R;
        voffA[i] = (unsigned)(R * K + C) * 2u; voffB[i] = (unsigned)(Rb * K + C) * 2u; }
    const size_t kstep = (size_t)(BK * 2);
    const size_t hstep = (size_t)HALF * K * 2;
    const size_t tstep = 2 * hstep;
    const unsigned ldsw = (unsigned)wid * 1024u;
    const int aoff = lds_byte(wr * 64 + fr, fq * 8), boff = lds_byte(wc * 32 + fr, fq * 8);
#define PG8_SA(b, h) (((b) * 2 + (h)) * HTB)
#define PG8_SB(b, h) ((4 + (b) * 2 + (h)) * HTB)
#define PG8_STAGE(bufoff, gbase, voff) do { _Pragma("unroll") for (int _i = 0; _i < 2; ++_i) \
        __builtin_amdgcn_global_load_lds((const unsigned*)((const char*)(gbase) + (voff)[_i]), (PG8_LAS unsigned*)(lds + (bufoff) + ldsw + _i * 8192), 16, 0, 0); } while (0)
#define PG8_LDA(dst, b, h) do { _Pragma("unroll") for (int m = 0; m < 4; ++m) _Pragma("unroll") for (int k = 0; k < 2; ++k) dst[m][k] = *(const PG8_LAS bf16x8*)(lds + PG8_SA(b, h) + aoff + m * 2048 + k * 1024); } while (0)
#define PG8_LDB(dst, b, h) do { _Pragma("unroll") for (int n = 0; n < 2; ++n) _Pragma("unroll") for (int k = 0; k < 2; ++k) dst[n][k] = *(const PG8_LAS bf16x8*)(lds + PG8_SB(b, h) + boff + n * 2048 + k * 1024); } while (0)
#define PG8_MMA(ai, bj, At, Bt) do { __builtin_amdgcn_s_setprio(1); _Pragma("unroll") for (int m = 0; m < 4; ++m) _Pragma("unroll") for (int n = 0; n < 2; ++n) _Pragma("unroll") for (int k = 0; k < 2; ++k) \
        acc[ai][bj][m][n] = __builtin_amdgcn_mfma_f32_16x16x32_bf16(Bt[n][k], At[m][k], acc[ai][bj][m][n], 0, 0, 0); __builtin_amdgcn_s_setprio(0); } while (0)
#define PG8_WAIT_V(n) asm volatile("s_waitcnt vmcnt(" #n ")" ::: "memory")
#define PG8_WAIT_L(n) asm volatile("s_waitcnt lgkmcnt(" #n ")" ::: "memory")
#define PG8_BAR __builtin_amdgcn_s_barrier()
#define PG8_SCHED __builtin_amdgcn_sched_barrier(0)
    Unit cur, nxt; int ui = 0;
    if (!S.next(0, cur)) return;
    f32x4 acc[2][2][4][2];
#pragma unroll
    for (int a = 0; a < 2; ++a)
#pragma unroll
        for (int b = 0; b < 2; ++b)
#pragma unroll
            for (int m = 0; m < 4; ++m)
#pragma unroll
                for (int n = 0; n < 2; ++n) acc[a][b][m][n] = (f32x4){0.f, 0.f, 0.f, 0.f};
    bf16x8 At[4][2], B0[2][2], B1[2][2];
    const char* cA = (const char*)g.A + (size_t)cur.pm * tstep; const char* cB = (const char*)g.Bt + (size_t)cur.pn * tstep;
    S.a_ready(cur);
    if constexpr (SP2) {
        PG8_STAGE(PG8_SB(0, 0), cB, voffB); PG8_STAGE(PG8_SB(0, 1), cB + hstep, voffB); PG8_STAGE(PG8_SA(0, 0), cA, voffA); PG8_STAGE(PG8_SA(0, 1), cA + hstep, voffA);
        if (wr == 1) PG8_BAR;
        PG8_WAIT_V(2); PG8_BAR;
        PG8_STAGE(PG8_SB(1, 0), cB + kstep, voffB); PG8_STAGE(PG8_SA(1, 0), cA + kstep, voffA); PG8_STAGE(PG8_SB(1, 1), cB + hstep + kstep, voffB);
        PG8_WAIT_V(6); PG8_BAR;
    } else {
        PG8_STAGE(PG8_SB(0, 0), cB, voffB); PG8_STAGE(PG8_SA(0, 0), cA, voffA); PG8_STAGE(PG8_SB(0, 1), cB + hstep, voffB); PG8_STAGE(PG8_SA(0, 1), cA + hstep, voffA);
        if (wr == 1) PG8_BAR;
        PG8_WAIT_V(4); PG8_BAR;
        PG8_STAGE(PG8_SB(1, 0), cB + kstep, voffB); PG8_STAGE(PG8_SA(1, 0), cA + kstep, voffA); PG8_STAGE(PG8_SB(1, 1), cB + hstep + kstep, voffB);
        PG8_WAIT_V(6); PG8_BAR;
    }
    for (;;) {
        const bool has_next = S.next(ui + 1, nxt);
        const char* nA = has_next ? (const char*)g.A + (size_t)nxt.pm * tstep : cA; const char* nB = has_next ? (const char*)g.Bt + (size_t)nxt.pn * tstep : cB;
        for (int t = 0; t < nt; t += 2) {
            const bool last = (t == nt - 2);
            const char* a1 = cA + (size_t)(t + 1) * kstep;
            const char* a2 = last ? nA : cA + (size_t)(t + 2) * kstep; const char* b2 = last ? nB : cB + (size_t)(t + 2) * kstep;
            const char* a3 = a2 + kstep; const char* b3 = b2 + kstep;
            if (last && has_next) S.a_ready(nxt);
            if constexpr (SP2) {
            PG8_LDB(B0, 0, 0); PG8_LDB(B1, 0, 1); PG8_SCHED; PG8_LDA(At, 0, 0); PG8_STAGE(PG8_SA(1, 1), a1 + hstep, voffA);
            PG8_WAIT_V(8); PG8_WAIT_L(0); PG8_BAR; PG8_MMA(0, 0, At, B0); PG8_MMA(0, 1, At, B1); PG8_BAR; PG8_SCHED;
            PG8_LDA(At, 0, 1); PG8_STAGE(PG8_SB(0, 0), b2, voffB); PG8_STAGE(PG8_SB(0, 1), b2 + hstep, voffB); PG8_STAGE(PG8_SA(0, 0), a2, voffA);
            PG8_WAIT_V(8); PG8_WAIT_L(0); PG8_BAR; PG8_MMA(1, 0, At, B0); PG8_MMA(1, 1, At, B1); PG8_BAR; PG8_SCHED;
            PG8_LDB(B0, 1, 0); PG8_LDB(B1, 1, 1); PG8_SCHED; PG8_LDA(At, 1, 0); PG8_STAGE(PG8_SA(0, 1), a2 + hstep, voffA);
            PG8_WAIT_V(8); PG8_WAIT_L(0); PG8_BAR; PG8_MMA(0, 0, At, B0); PG8_MMA(0, 1, At, B1); PG8_BAR; PG8_SCHED;
            PG8_LDA(At, 1, 1); PG8_STAGE(PG8_SB(1, 0), b3, voffB); PG8_STAGE(PG8_SB(1, 1), b3 + hstep, voffB); PG8_STAGE(PG8_SA(1, 0), a3, voffA);
            PG8_WAIT_V(8); PG8_WAIT_L(0); PG8_BAR; PG8_MMA(1, 0, At, B0); PG8_MMA(1, 1, At, B1); PG8_BAR; PG8_SCHED;
            } else {
            PG8_LDB(B0, 0, 0); PG8_SCHED; PG8_LDA(At, 0, 0); PG8_STAGE(PG8_SA(1, 1), a1 + hstep, voffA);
            PG8_WAIT_L(8); PG8_BAR; PG8_WAIT_L(0); PG8_MMA(0, 0, At, B0); PG8_BAR; PG8_SCHED;
            PG8_LDB(B1, 0, 1); PG8_STAGE(PG8_SB(0, 0), b2, voffB);
            PG8_BAR; PG8_WAIT_L(0); PG8_MMA(0, 1, At, B1); PG8_BAR;
            PG8_LDA(At, 0, 1); PG8_STAGE(PG8_SA(0, 0), a2, voffA);
            PG8_BAR; PG8_WAIT_L(0); PG8_MMA(1, 0, At, B0); PG8_BAR; PG8_SCHED;
            PG8_STAGE(PG8_SB(0, 1), b2 + hstep, voffB);
            PG8_WAIT_V(6); PG8_BAR; PG8_MMA(1, 1, At, B1); PG8_BAR;
            PG8_LDB(B0, 1, 0); PG8_SCHED; PG8_LDA(At, 1, 0); PG8_STAGE(PG8_SA(0, 1), a2 + hstep, voffA);
            PG8_WAIT_L(8); PG8_BAR; PG8_WAIT_L(0); PG8_MMA(0, 0, At, B0); PG8_BAR; PG8_SCHED;
            PG8_LDB(B1, 1, 1); PG8_STAGE(PG8_SB(1, 0), b3, voffB);
            PG8_BAR; PG8_WAIT_L(0); PG8_MMA(0, 1, At, B1); PG8_BAR;
            PG8_LDA(At, 1, 1); PG8_STAGE(PG8_SA(1, 0), a3, voffA);
            PG8_BAR; PG8_WAIT_L(0); PG8_MMA(1, 0, At, B0); PG8_BAR; PG8_SCHED;
            PG8_STAGE(PG8_SB(1, 1), b3 + hstep, voffB);
            PG8_WAIT_V(6); PG8_BAR; PG8_MMA(1, 1, At, B1); PG8_BAR;
            }
        }
        if constexpr (ALIGN_EPI) { if (wr == 0) PG8_BAR; }
        if constexpr (!Epi::AFTER_DRAIN) { E(acc, cur, wr, wc, fr, fq); S.done(cur); }
        if (!has_next) break;
#pragma unroll
        for (int a = 0; a < 2; ++a)
#pragma unroll
            for (int b = 0; b < 2; ++b)
#pragma unroll
                for (int m = 0; m < 4; ++m)
#pragma unroll
                    for (int n = 0; n < 2; ++n) acc[a][b][m][n] = (f32x4){0.f, 0.f, 0.f, 0.f};
        cur = nxt; cA = nA; cB = nB; ++ui;
        if constexpr (ALIGN_EPI) { if (wr == 1) PG8_BAR; }
    }
    PG8_WAIT_V(0);
    if constexpr (!ALIGN_EPI) { if (wr == 0) PG8_BAR; }
    PG8_BAR;
    if constexpr (Epi::AFTER_DRAIN) { E.fused(acc, cur, wr, wc, fr, fq, lds, wid, lane); S.done(cur); }
#undef PG8_SA
#undef PG8_SB
#undef PG8_STAGE
#undef PG8_LDA
#undef PG8_LDB
#undef PG8_MMA
#undef PG8_WAIT_V
#undef PG8_WAIT_L
#undef PG8_BAR
#undef PG8_SCHED
}
}

typedef short bf16x8 __attribute__((ext_vector_type(8)));
typedef short s16x4 __attribute__((ext_vector_type(4)));
typedef short v4i16_t __attribute__((ext_vector_type(4)));
typedef float f32x16 __attribute__((ext_vector_type(16)));
typedef LAS const char* lds_cptr;
__device__ __forceinline__ int crow(int r, int hi) { return (r & 3) + 8 * (r >> 2) + 4 * hi; }
__device__ __forceinline__ s16x4 vtr(lds_cptr p) { return __builtin_bit_cast(s16x4, __builtin_amdgcn_ds_read_tr16_b64_v4i16((LAS v4i16_t*)p)); }
__device__ __forceinline__ unsigned cvtpk(float lo, float hi) { unsigned r; asm volatile("v_cvt_pk_bf16_f32 %0, %1, %2" : "=v"(r) : "v"(lo), "v"(hi)); return r; }
__device__ __forceinline__ float swap32_max(float v) { auto rr = __builtin_amdgcn_permlane32_swap(__float_as_uint(v), __float_as_uint(v), false, false); return fmaxf(__uint_as_float(rr[0]), __uint_as_float(rr[1])); }
__device__ __forceinline__ float swap32_sum(float v) { auto rr = __builtin_amdgcn_permlane32_swap(__float_as_uint(v), __float_as_uint(v), false, false); return __uint_as_float(rr[0]) + __uint_as_float(rr[1]); }
#define MFMA32(a, b, c) __builtin_amdgcn_mfma_f32_32x32x16_bf16((a), (b), (c), 0, 0, 0)

constexpr int DA_KOFF = 0, DA_VOFF = 16384, DA_BUF = 32768, DA_WS = 65536, DA_DIFF = 69632, DA_DPITCH = 132;
__device__ __forceinline__ void fast_diffattn_unit(int b, int h, int qblk, LAS unsigned char* lds, const bf16_t* proj, float lam, const float* subln, bf16_t* Y, int ypitch) {
    const int tid = threadIdx.x, lane = tid & 63, wave = __builtin_amdgcn_readfirstlane(tid >> 6), r32 = lane & 31, hh = lane >> 5, mp = wave >> 2, qs = wave & 3;
    const int q0 = qblk * 128 + qs * 32;
    const size_t rowbase = (size_t)b * SEQ;
    bf16x8 qf[4];
#pragma unroll
    for (int ds = 0; ds < 4; ++ds) qf[ds] = *(const bf16x8*)(proj + (rowbase + q0 + r32) * PROJ_P + CQ + h * 128 + mp * 64 + ds * 16 + hh * 8);
    const float slope2 = exp2f(-(float)(h + 1)) * LOG2E, sc2 = 0.125f * LOG2E;
    f32x16 o[4];
#pragma unroll
    for (int d = 0; d < 4; ++d)
#pragma unroll
        for (int r = 0; r < 16; ++r) o[d][r] = 0.f;
    float m = -1e30f, l = 0.f;
    LAS float* wsf = (LAS float*)(lds + DA_WS) + wave * 64;
    const int T = 2 * (qblk + 1);
    const bf16_t* ksrc = proj + (rowbase + lane) * PROJ_P + CK + h * 128 + wave * 8;
    const bf16_t* vsrc = proj + (rowbase + 16 * (wave & 3) + (lane >> 2)) * PROJ_P + CV + h * 128 + (wave >> 2) * 32 + (lane & 3) * 8;
    const int kdst = DA_KOFF + wave * 1024 + lane * 16, vdst = DA_VOFF + wave * 1024 + lane * 16;
    u32x4 kr[2], vr[2];
#define DA_LOAD(t) do { const size_t to_ = (size_t)(t) * 64 * PROJ_P; kr[0] = *(const u32x4*)(ksrc + to_); kr[1] = *(const u32x4*)(ksrc + to_ + 64); vr[0] = *(const u32x4*)(vsrc + to_); vr[1] = *(const u32x4*)(vsrc + to_ + 64); } while (0)
#define DA_WRITE(bo) do { *(LAS u32x4*)(lds + (bo) + kdst) = kr[0]; *(LAS u32x4*)(lds + (bo) + kdst + 8192) = kr[1]; *(LAS u32x4*)(lds + (bo) + vdst) = vr[0]; *(LAS u32x4*)(lds + (bo) + vdst + 8192) = vr[1]; } while (0)
    DA_LOAD(T - 1); DA_WRITE(0);
    __syncthreads();
    const int kfo = (8 * mp + hh) * 1024 + r32 * 16;
    const int vfo = DA_VOFF + ((lane >> 4) & 1) * 32 + (lane & 3) * 8 + (4 * hh + ((lane & 15) >> 2)) * 64;
    for (int it = 0; it < T; ++it) {
        const int t = T - 1 - it, bo = (it & 1) * DA_BUF;
        if (it + 1 < T) DA_LOAD(t - 1);
        if (64 * t <= q0 + 31) {
            lds_cptr kb = (lds_cptr)(lds + bo + kfo);
            f32x16 s0, s1;
#pragma unroll
            for (int r = 0; r < 16; ++r) { s0[r] = 0.f; s1[r] = 0.f; }
#pragma unroll
            for (int ds = 0; ds < 4; ++ds) {
                const bf16x8 a0 = *(const LAS bf16x8*)(kb + ds * 2048), a1 = *(const LAS bf16x8*)(kb + ds * 2048 + 512);
                s0 = MFMA32(a0, qf[ds], s0); s1 = MFMA32(a1, qf[ds], s1);
            }
            const float tb = slope2 * (float)(64 * t + 4 * hh - q0);
#pragma unroll
            for (int r = 0; r < 16; ++r) { const float c = slope2 * (float)((r & 3) + 8 * (r >> 2)) + tb; s0[r] = s0[r] * sc2 + c; s1[r] = s1[r] * sc2 + (c + 32.f * slope2); }
            if (64 * t + 63 > q0) {
                const int qrel = q0 + r32 - 64 * t - 4 * hh;
#pragma unroll
                for (int r = 0; r < 16; ++r) { const int kv = (r & 3) + 8 * (r >> 2); if (kv > qrel) s0[r] = -INFINITY; if (kv + 32 > qrel) s1[r] = -INFINITY; }
            }
            float mx = fmaxf(s0[0], s1[0]);
#pragma unroll
            for (int r = 1; r < 16; ++r) mx = fmaxf(mx, fmaxf(s0[r], s1[r]));
            mx = swap32_max(mx);
            if (__any(mx > m + 8.f)) {
                const float mn = fmaxf(m, mx), al = __builtin_amdgcn_exp2f(m - mn);
                m = mn; l *= al;
                if (hh == 0) wsf[r32] = al;
#pragma unroll
                for (int r = 0; r < 16; ++r) { const float ar = wsf[crow(r, hh)];
#pragma unroll
                    for (int d = 0; d < 4; ++d) o[d][r] *= ar; }
            }
            float ps = 0.f;
#pragma unroll
            for (int r = 0; r < 16; ++r) { s0[r] = __builtin_amdgcn_exp2f(s0[r] - m); s1[r] = __builtin_amdgcn_exp2f(s1[r] - m); ps += s0[r] + s1[r]; }
            l += ps;
            u32x4 pw[4];
#pragma unroll
            for (int k = 0; k < 2; ++k)
#pragma unroll
                for (int j = 0; j < 4; ++j) { pw[k][j] = cvtpk(s0[8 * k + 2 * j], s0[8 * k + 2 * j + 1]); pw[2 + k][j] = cvtpk(s1[8 * k + 2 * j], s1[8 * k + 2 * j + 1]); }
            lds_cptr vb = (lds_cptr)(lds + bo + vfo);
#pragma unroll
            for (int d = 0; d < 4; ++d)
#pragma unroll
                for (int ks = 0; ks < 4; ++ks) {
                    const s16x4 lo = vtr(vb + d * 4096 + ks * 1024), hi = vtr(vb + d * 4096 + ks * 1024 + 512);
                    const bf16x8 vf = (bf16x8){lo[0], lo[1], lo[2], lo[3], hi[0], hi[1], hi[2], hi[3]};
                    o[d] = MFMA32(__builtin_bit_cast(bf16x8, pw[ks]), vf, o[d]);
                }
        }
        if (it + 1 < T) DA_WRITE(((it + 1) & 1) * DA_BUF);
        __syncthreads();
    }
#undef DA_LOAD
#undef DA_WRITE
    l = swap32_sum(l);
    if (hh == 0) wsf[r32] = 1.f / l;
    float inv[16];
#pragma unroll
    for (int r = 0; r < 16; ++r) inv[r] = wsf[crow(r, hh)];
    LAS float* exch = (LAS float*)lds + qs * 4096;
    if (mp == 1) {
#pragma unroll
        for (int d = 0; d < 4; ++d)
#pragma unroll
            for (int r = 0; r < 16; ++r) exch[(d * 16 + r) * 64 + lane] = o[d][r] * inv[r] * lam;
    }
    __syncthreads();
    LAS float* dimg = (LAS float*)(lds + DA_DIFF);
    if (mp == 0) {
#pragma unroll
        for (int d = 0; d < 4; ++d)
#pragma unroll
            for (int r = 0; r < 16; ++r) dimg[(qs * 32 + crow(r, hh)) * DA_DPITCH + d * 32 + r32] = o[d][r] * inv[r] - exch[(d * 16 + r) * 64 + lane];
    }
    __syncthreads();
    {
        const int row = tid >> 2, qt = tid & 3; const size_t grow = rowbase + qblk * 128 + row;
        f32x4 dv[8]; float ss = 0.f;
#pragma unroll
        for (int i = 0; i < 8; ++i) { dv[i] = *(const LAS f32x4*)(dimg + row * DA_DPITCH + qt * 32 + 4 * i); ss += (dv[i][0] * dv[i][0] + dv[i][1] * dv[i][1]) + (dv[i][2] * dv[i][2] + dv[i][3] * dv[i][3]); }
        ss += __shfl_xor(ss, 1); ss += __shfl_xor(ss, 2);
        const float rn = (1.f - LAMBDA_INIT) / sqrtf(ss * (1.f / 128.f) + EPS);
        const u32x4* gp = (const u32x4*)(proj + grow * PROJ_P + CGA + h * 128 + qt * 32); u32x4* yp = (u32x4*)(Y + grow * ypitch + h * 128 + qt * 32);
        const f32x4* wp = (const f32x4*)(subln + qt * 32);
#pragma unroll
        for (int i = 0; i < 4; ++i) { const u32x4 g = gp[i]; const f32x4 w0 = wp[2 * i], w1 = wp[2 * i + 1], d0 = dv[2 * i], d1 = dv[2 * i + 1]; u32x4 y;
            y.x = pk2(d0[0] * rn * w0[0] * silu_f(bf2f(g.x & 0xffffu)), d0[1] * rn * w0[1] * silu_f(bf2f(g.x >> 16)));
            y.y = pk2(d0[2] * rn * w0[2] * silu_f(bf2f(g.y & 0xffffu)), d0[3] * rn * w0[3] * silu_f(bf2f(g.y >> 16)));
            y.z = pk2(d1[0] * rn * w1[0] * silu_f(bf2f(g.z & 0xffffu)), d1[1] * rn * w1[1] * silu_f(bf2f(g.z >> 16)));
            y.w = pk2(d1[2] * rn * w1[2] * silu_f(bf2f(g.w & 0xffffu)), d1[3] * rn * w1[3] * silu_f(bf2f(g.w >> 16)));
            yp[i] = y; }
    }
    __syncthreads();
}

#include <hip/hip_cooperative_groups.h>
namespace cg = cooperative_groups;
#define GAS __attribute__((address_space(1)))
#define LDS_WAIT() asm volatile("s_waitcnt lgkmcnt(0)" ::: "memory")
constexpr int NWAVES = 8, NTHREADS = NWAVES * 64;
constexpr int RING_BYTES = 131072, LDS_BYTES = 147456;
constexpr int NPHASE = 9;

struct Args { const float* in[21]; float* out; unsigned char* ws; unsigned char* alt; int ph_lo, ph_hi, fast, altpitch; };

__device__ __forceinline__ void p0_transpose_item(const float* W, const float* s, int K, int N, bf16_t* WT, LAS float* scr, int item, int nblk, int lane) {
    const int kb = item / nblk, nb = item % nblk, k0 = 64 * kb, n0 = 32 * nb, n = n0 + (lane & 31);
    const bool ok = n < N;
#pragma unroll 8
    for (int i = 0; i < 32; ++i) { const int kk = 2 * i + (lane >> 5); float v = ok ? W[(size_t)(k0 + kk) * N + n] : 0.f; if (s) v *= s[k0 + kk]; scr[kk * 33 + (lane & 31)] = v; }
    LDS_WAIT(); asm volatile("" ::: "memory");
    const int c = lane & 7;
#pragma unroll
    for (int j = 0; j < 4; ++j) { const int nn = (lane >> 3) + 8 * j; const LAS float* sp = scr + (8 * c) * 33 + nn;
        u32x4 o; o.x = pk2(sp[0 * 33], sp[1 * 33]); o.y = pk2(sp[2 * 33], sp[3 * 33]); o.z = pk2(sp[4 * 33], sp[5 * 33]); o.w = pk2(sp[6 * 33], sp[7 * 33]);
        *(u32x4*)(WT + (size_t)(n0 + nn) * K + k0 + 8 * c) = o; }
    LDS_WAIT(); asm volatile("" ::: "memory");
}

__global__ void __launch_bounds__(NTHREADS, 2) mega(Args a) {
    extern __shared__ __attribute__((aligned(16))) unsigned char lds[];
    cg::grid_group grid = cg::this_grid();
    const int tid = threadIdx.x, lane = tid & 63, wave = __builtin_amdgcn_readfirstlane(tid >> 6);
    const int G = gridDim.x, bx = blockIdx.x, vcu = (G % 8 == 0) ? (bx % 8) * (G / 8) + bx / 8 : bx;
    const int gw = vcu * NWAVES + wave, NGW = G * NWAVES;
    unsigned char* ws = a.ws;
    const float* x = a.in[0];
    bf16_t* WA = (bf16_t*)(ws + WS_WA); bf16_t* WOA = (bf16_t*)(ws + WS_WOA); bf16_t* WC = (bf16_t*)(ws + WS_WC); bf16_t* WOC = (bf16_t*)(ws + WS_WOC);
    float* DT = (float*)(ws + WS_DT); float* SSQ = (float*)(ws + WS_SSQ); float* RSTD0 = (float*)(ws + WS_RSTD0); float* SSQ1 = (float*)(ws + WS_SSQ1);
    bf16_t* PROJ = (bf16_t*)(ws + WS_PROJ); float* X1 = (float*)(ws + WS_X1); bf16_t* XB1 = (bf16_t*)(ws + WS_XB1); bf16_t* PROJC = (bf16_t*)(ws + WS_PROJC); bf16_t* OGb = (bf16_t*)(ws + WS_OG);
    bf16_t* XB = (bf16_t*)a.out; bf16_t* Y = (bf16_t*)a.out;
    const int lo = a.ph_lo, hi = a.ph_hi;
#define IN(k) (lo <= (k) && (k) < hi)
#define SEAM(k) do { if (IN(k) && IN((k) + 1)) grid.sync(); } while (0)

    if (IN(0)) {
        LAS float* scr = (LAS float*)((LAS unsigned char*)lds + wave * 16384);
        constexpr int I_A = (DM / 64) * (NA_PAD / 32), I_OA = (2048 / 64) * (DM / 32), I_C = (DM / 64) * (ODD_IN / 32), I_OC = (DM / 64) * (DM / 32);
        for (int it = gw; it < I_A + I_OA + I_C + I_OC; it += NGW) {
            int r = it;
            if (r < I_A) { p0_transpose_item(a.in[2], a.in[1], DM, EVEN_IN, WA, scr, r, NA_PAD / 32, lane); continue; } r -= I_A;
            if (r < I_OA) { p0_transpose_item(a.in[14], nullptr, 2048, DM, WOA, scr, r, DM / 32, lane); continue; } r -= I_OA;
            if (r < I_C) { p0_transpose_item(a.in[16], a.in[15], DM, ODD_IN, WC, scr, r, ODD_IN / 32, lane); continue; } r -= I_C;
            p0_transpose_item(a.in[19], nullptr, DM, DM, WOC, scr, r, DM / 32, lane);
        }
        for (int m = gw; m < MROWS; m += NGW) {
            const f32x4* xr = (const f32x4*)(x + (size_t)m * DM) + lane; float s = 0.f;
            unsigned long long* o8 = (unsigned long long*)(XB + (size_t)m * DM) + lane;
#pragma unroll
            for (int j = 0; j < 4; ++j) { const f32x4 v = xr[64 * j]; s += (v.x * v.x + v.y * v.y) + (v.z * v.z + v.w * v.w); o8[64 * j] = (unsigned long long)pk2(v.x, v.y) | ((unsigned long long)pk2(v.z, v.w) << 32); }
            s = wave_sum(s);
            if (lane == 0) RSTD0[m] = 1.f / sqrtf(s * (1.f / DM) + EPS);
        }
    }
    SEAM(0);
    if (IN(1)) {
        pg8::Gemm g{XB, WA, MROWS, NA_PAD, DM}; pg8::StaticOrder S; S.init(MROWS, NA_PAD, G, bx);
        pg8::EpiProjA E{PROJ, DT, RSTD0, PROJ_P, PROJ_P / 256};
        pg8::gemm_phase<pg8::EpiProjA, pg8::StaticOrder, true, true>((LAS unsigned char*)lds, g, S, E);
    }
    SEAM(1);
    if (IN(2)) {
        if (a.fast & 1) {
            float s1 = 0.f, s2 = 0.f; for (int i = 0; i < 64; ++i) { s1 += a.in[9][i] * a.in[10][i]; s2 += a.in[11][i] * a.in[12][i]; }
            const float lam = __expf(s1) - __expf(s2) + LAMBDA_INIT;
            bf16_t* Yo = a.alt ? (bf16_t*)a.alt : Y; const int yp = a.alt ? a.altpitch : 2048;
            for (int ug = vcu; ug < 256; ug += G) { const int bh = ug >> 1, sub = ug & 1;
                for (int i = 0; i < 8; ++i) { const int j = 2 * (i >> 1) + sub, qblk = (i & 1) ? 15 - j : j; fast_diffattn_unit(bh >> 3, bh & 7, qblk, (LAS unsigned char*)lds, PROJ, lam, a.in[13], Yo, yp); } }
        } else
        for (int u = bx; u < 2048; u += G) slow_diffattn_unit(u, tid, PROJ, a.in[9], a.in[10], a.in[11], a.in[12], a.in[13], Y);
        for (int pr = bx; pr < 128; pr += G) slow_ssd_pair(pr, tid, (LAS float*)lds, PROJ, DT, a.in[3], a.in[4], a.in[5], a.in[6], a.in[7], Y, SSQ);
    }
    SEAM(2);
    if (IN(3)) {
        const float* w = a.in[8];
        for (int m = gw; m < MROWS; m += NGW) {
            const float* sq = SSQ + (size_t)m * 16;
#pragma unroll
            for (int g = 0; g < 2; ++g) {
                float s = 0.f;
#pragma unroll
                for (int i = 0; i < 8; ++i) s += sq[g * 8 + i];
                const float r = 1.f / sqrtf(s * (1.f / 512.f) + EPS);
                u32x4* yp = (u32x4*)(Y + (size_t)m * 2048 + 1024 + g * 512) + lane; const float* wp = w + g * 512 + lane * 8;
                u32x4 v = *yp;
#pragma unroll
                for (int i = 0; i < 4; ++i) v[i] = pk2(bf2f(v[i] & 0xffffu) * r * wp[2 * i], bf2f(v[i] >> 16) * r * wp[2 * i + 1]);
                *yp = v;
            }
        }
    }
    SEAM(3);
    if (IN(4)) {
        pg8::Gemm g{Y, WOA, MROWS, DM, 2048}; pg8::StaticOrder S; S.init(MROWS, DM, G, bx);
        pg8::EpiRes E{x, X1, XB1, SSQ1, DM};
        pg8::gemm_phase<pg8::EpiRes, pg8::StaticOrder, true, true>((LAS unsigned char*)lds, g, S, E);
    }
    SEAM(4);
    if (IN(5)) {
        pg8::Gemm g{XB1, WC, MROWS, ODD_IN, DM}; pg8::StaticOrder S; S.init(MROWS, ODD_IN, G, bx);
        pg8::EpiProjC E{PROJC, SSQ1, a.in[17], ODD_IN, 1.f / DM, EPS};
        pg8::gemm_phase<pg8::EpiProjC, pg8::StaticOrder, true, true>((LAS unsigned char*)lds, g, S, E);
    }
    SEAM(5);
    if (IN(6)) {
        for (int u = bx; u < 1024; u += G) slow_swa_unit(u, tid, PROJC, a.in[18], OGb);
    }
    SEAM(6);
    if (IN(7)) {
        pg8::Gemm g{OGb, WOC, MROWS, DM, DM}; pg8::StaticOrder S; S.init(MROWS, DM, G, bx);
        pg8::EpiRes E{X1, X1, nullptr, nullptr, DM};
        pg8::gemm_phase<pg8::EpiRes, pg8::StaticOrder, true, true>((LAS unsigned char*)lds, g, S, E);
    }
    SEAM(7);
    if (IN(8)) {
        const f32x4* wr = (const f32x4*)a.in[20] + lane;
        for (int m = gw; m < MROWS; m += NGW) {
            const f32x4* xr = (const f32x4*)(X1 + (size_t)m * DM) + lane; f32x4 v[4]; float s = 0.f;
#pragma unroll
            for (int j = 0; j < 4; ++j) { v[j] = xr[64 * j]; s += (v[j].x * v[j].x + v[j].y * v[j].y) + (v[j].z * v[j].z + v[j].w * v[j].w); }
            s = wave_sum(s); const float r = 1.f / sqrtf(s * (1.f / DM) + EPS);
            f32x4* o = (f32x4*)(a.out + (size_t)m * DM) + lane;
#pragma unroll
            for (int j = 0; j < 4; ++j) o[64 * j] = v[j] * r * wr[64 * j];
        }
    }
#undef IN
#undef SEAM
}

#ifndef DEBUG_CMP
#define DEBUG_CMP 0
#endif
#ifndef FAST_MASK
#define FAST_MASK 1
#endif
#ifndef CMP_R0
#define CMP_R0 0
#define CMP_R1 2048
#define CMP_C0 0
#define CMP_C1 1024
#endif
constexpr size_t WS_ALT = 448 * MiB;
__global__ void __launch_bounds__(256) k_cmp_bf16(const bf16_t* A, int pa, const bf16_t* B, int pb, int ncol, int r0, int r1, int c0, int c1, float* met) {
    float sd = 0.f, sr = 0.f;
    for (size_t i = (size_t)blockIdx.x * 256 + threadIdx.x; i < (size_t)MROWS * ncol; i += (size_t)gridDim.x * 256) {
        const int row = (int)(i / ncol), col = (int)(i % ncol), sp = row % SEQ;
        if (sp < r0 || sp >= r1 || col < c0 || col >= c1) continue;
        const float x = bf2f(A[(size_t)row * pa + col]), y = bf2f(B[(size_t)row * pb + col]); const float d = x - y;
        sd += (d == d) ? d * d : 1e6f; sr += x * x;
    }
    sd = wave_sum(sd); sr = wave_sum(sr);
    if ((threadIdx.x & 63) == 0) { atomicAdd(met, sd); atomicAdd(met + 1, sr); }
}
__global__ void __launch_bounds__(256) k_inject(float* out, const float* met) {
    const float rel = fminf(sqrtf(met[0] / fmaxf(met[1], 1e-30f)), 3.f);
    f32x4* o = (f32x4*)out + (size_t)blockIdx.x * 256 + threadIdx.x; *o = *o * (1.f + rel);
}
static int g_grid = 0;
static void launch_mega(const Args& base, int lo, int hi, hipStream_t stream) {
    Args a = base; a.ph_lo = lo; a.ph_hi = hi; void* params[] = {&a};
    hipError_t e = hipLaunchCooperativeKernel((const void*)mega, dim3(g_grid), dim3(NTHREADS), params, LDS_BYTES, stream);
    if (e != hipSuccess) fprintf(stderr, "kernel_launch: cooperative launch [%d,%d) failed: %s (grid %d)\n", lo, hi, hipGetErrorString(e), g_grid);
}
extern "C" void kernel_launch(void* const* d_in, const int* in_sizes, int n_in, void* d_out, int out_size, void* d_ws, size_t ws_size, hipStream_t stream) {
    if (n_in != 21 || in_sizes[0] != MROWS * DM || out_size != MROWS * DM || ws_size < WS_END) { fprintf(stderr, "kernel_launch: unexpected shapes (n_in %d, ws %zu)\n", n_in, ws_size); return; }
    if (g_grid == 0) {
        int dev = 0, cus = 0, per_cu = 0;
        (void)hipGetDevice(&dev); (void)hipDeviceGetAttribute(&cus, hipDeviceAttributeMultiprocessorCount, dev);
        if (hipFuncSetAttribute((const void*)mega, hipFuncAttributeMaxDynamicSharedMemorySize, LDS_BYTES) != hipSuccess) { fprintf(stderr, "kernel_launch: hipFuncSetAttribute failed\n"); g_grid = -1; return; }
        if (hipOccupancyMaxActiveBlocksPerMultiprocessor(&per_cu, (const void*)mega, NTHREADS, LDS_BYTES) != hipSuccess || per_cu < 1) { fprintf(stderr, "kernel_launch: occupancy query says %d blocks per CU\n", per_cu); g_grid = -1; return; }
        g_grid = cus;
        fprintf(stderr, "kernel_launch: %d CUs, %d blocks/CU admitted, grid %d\n", cus, per_cu, g_grid);
    }
    if (g_grid < 0) return;
    unsigned char* ws = (unsigned char*)d_ws;
    Args a{}; for (int i = 0; i < 21; ++i) a.in[i] = (const float*)d_in[i];
    a.out = (float*)d_out; a.ws = ws; a.fast = FAST_MASK;
#if DEBUG_CMP == 0
    launch_mega(a, 0, NPHASE, stream);
#else
    float* met = (float*)(ws + WS_CTL);
    (void)hipMemsetAsync(met, 0, 256, stream);
    a.fast = 0; launch_mega(a, 0, 3, stream);
    Args f = a; f.fast = FAST_MASK;
#if DEBUG_CMP == 1
    f.alt = ws + WS_ALT; f.altpitch = 1024; launch_mega(f, 2, 3, stream);
    k_cmp_bf16<<<1024, 256, 0, stream>>>((const bf16_t*)d_out, 2048, (const bf16_t*)(ws + WS_ALT), 1024, 1024, CMP_R0, CMP_R1, CMP_C0, CMP_C1, met);
#endif
    launch_mega(a, 3, NPHASE, stream);
    k_inject<<<MROWS * DM / 4 / 256, 256, 0, stream>>>((float*)d_out, met);
#endif
}
```

```cpp
#include <hip/hip_runtime.h>
#include <cstdio>
#include <cstdint>
#include <cmath>

typedef unsigned short bf16_t;
typedef unsigned u32x4 __attribute__((ext_vector_type(4)));
typedef float f32x4 __attribute__((ext_vector_type(4)));

constexpr int BATCH = 16, SEQ = 2048, DM = 1024, MROWS = BATCH * SEQ;
constexpr int EVEN_IN = 6672, PROJ_P = 6656, NA_PAD = 6912;
constexpr int CQ = 0, CK = 1024, CV = 2048, CGA = 3072, CZ = 4096, CXS = 5120, CBM = 6144, CCM = 6400, CDT = 6656;
constexpr int ODD_IN = 2304;
constexpr int OQ = 0, OK_ = 1024, OV = 1152, OG_ = 1280;
constexpr float EPS = 1e-5f;
constexpr float LAMBDA_INIT = 0.2f;
constexpr float LOG2E = 1.4426950408889634f;

constexpr size_t MiB = 1u << 20;
constexpr size_t WS_CTL = 0;
constexpr size_t WS_WA = 1 * MiB;
constexpr size_t WS_WOA = 15 * MiB;
constexpr size_t WS_WC = 19 * MiB;
constexpr size_t WS_WOC = 24 * MiB;
constexpr size_t WS_DT = 26 * MiB;
constexpr size_t WS_SSQ = 28 * MiB;
constexpr size_t WS_RSTD0 = 30 * MiB;
constexpr size_t WS_RSTD1 = 30 * MiB + 256 * 1024;
constexpr size_t WS_SSQ1 = WS_DT;
constexpr size_t WS_PROJ = 32 * MiB;
constexpr size_t WS_X1 = 32 * MiB;
constexpr size_t WS_XB1 = 160 * MiB;
constexpr size_t WS_PROJC = 224 * MiB;
constexpr size_t WS_OG = 368 * MiB;
constexpr size_t WS_END = 448 * MiB;

__device__ __forceinline__ unsigned f2bf(float f) { unsigned u = __builtin_bit_cast(unsigned, f); return (u + 0x7fffu + ((u >> 16) & 1u)) >> 16; }
__device__ __forceinline__ float bf2f(unsigned h) { return __builtin_bit_cast(float, h << 16); }
__device__ __forceinline__ unsigned pk2(float lo, float hi) { return f2bf(lo) | (f2bf(hi) << 16); }
__device__ __forceinline__ float silu_f(float v) { return v / (1.f + __expf(-v)); }
__device__ __forceinline__ float wave_sum(float v) {
#pragma unroll
    for (int o = 1; o < 64; o <<= 1) v += __shfl_xor(v, o);
    return v;
}

#define LAS __attribute__((address_space(3)))
__device__ __forceinline__ void slow_diffattn_unit(int unit, int tid, const bf16_t* proj, const float* lq1, const float* lk1, const float* lq2, const float* lk2, const float* subln, bf16_t* Y) {
    const int qb = unit & 15, h = (unit >> 4) & 7, b = unit >> 7, qi = tid >> 2, eq = tid & 3;
    const int qpos = qb * 128 + qi; const size_t row = (size_t)b * SEQ + qpos;
    float s1 = 0.f, s2 = 0.f; for (int i = 0; i < 64; ++i) { s1 += lq1[i] * lk1[i]; s2 += lq2[i] * lk2[i]; }
    const float lam = __expf(s1) - __expf(s2) + LAMBDA_INIT;
    const float slope = exp2f(-(float)(h + 1));
    float q0[16], q1[16];
    { const bf16_t* qp = proj + row * PROJ_P + CQ + h * 128 + eq * 16;
#pragma unroll
      for (int i = 0; i < 16; ++i) { q0[i] = bf2f(qp[i]); q1[i] = bf2f(qp[64 + i]); } }
    float o0[32], o1[32];
#pragma unroll
    for (int i = 0; i < 32; ++i) { o0[i] = 0.f; o1[i] = 0.f; }
    float m0 = -INFINITY, m1 = -INFINITY, l0 = 0.f, l1 = 0.f;
    const int jmax = qb * 128 + 127;
    for (int j = 0; j <= jmax; ++j) {
        const bf16_t* kp = proj + ((size_t)b * SEQ + j) * PROJ_P + CK + h * 128 + eq * 16;
        float d0 = 0.f, d1 = 0.f;
#pragma unroll
        for (int i = 0; i < 16; ++i) { d0 += q0[i] * bf2f(kp[i]); d1 += q1[i] * bf2f(kp[64 + i]); }
        d0 += __shfl_xor(d0, 1); d0 += __shfl_xor(d0, 2); d1 += __shfl_xor(d1, 1); d1 += __shfl_xor(d1, 2);
        if (j <= qpos) {
            const float bias = slope * (float)(qpos - j);
            const float a0 = d0 * 0.125f - bias, a1 = d1 * 0.125f - bias;
            const float n0 = fmaxf(m0, a0), n1 = fmaxf(m1, a1);
            const float c0 = __expf(m0 - n0), c1 = __expf(m1 - n1), p0 = __expf(a0 - n0), p1 = __expf(a1 - n1);
            m0 = n0; m1 = n1; l0 = l0 * c0 + p0; l1 = l1 * c1 + p1;
            const bf16_t* vp = proj + ((size_t)b * SEQ + j) * PROJ_P + CV + h * 128 + eq * 32;
#pragma unroll
            for (int i = 0; i < 32; ++i) { const float v = bf2f(vp[i]); o0[i] = o0[i] * c0 + p0 * v; o1[i] = o1[i] * c1 + p1 * v; }
        }
    }
    const float i0 = 1.f / l0, i1 = lam / l1; float ss = 0.f;
#pragma unroll
    for (int i = 0; i < 32; ++i) { o0[i] = o0[i] * i0 - o1[i] * i1; ss += o0[i] * o0[i]; }
    ss += __shfl_xor(ss, 1); ss += __shfl_xor(ss, 2);
    const float r = (1.f - LAMBDA_INIT) / sqrtf(ss * (1.f / 128.f) + EPS);
    const bf16_t* gp = proj + row * PROJ_P + CGA + h * 128 + eq * 32; bf16_t* yp = Y + row * 2048 + h * 128 + eq * 32;
#pragma unroll
    for (int i = 0; i < 32; ++i) yp[i] = (bf16_t)f2bf(o0[i] * r * subln[eq * 32 + i] * silu_f(bf2f(gp[i])));
}

__device__ __forceinline__ void slow_ssd_pair(int pair, int tid, LAS float* sm, const bf16_t* proj, const float* dtraw, const float* conv_w, const float* conv_b, const float* dt_bias, const float* a_log,
                                              const float* d_skip, bf16_t* Y, float* ssq) {
    const int half = tid >> 8, t = tid & 255, unit = pair * 2 + half, hd = unit & 15, b = unit >> 4, g = hd >> 3, p = t >> 2, nq = t & 3;
    LAS float* sB = sm + half * 272; LAS float* sC = sB + 128; LAS float* sRed = sB + 256;
    const int cbc = (t < 128) ? (1024 + g * 128 + t) : (1024 + 256 + g * 128 + (t - 128));
    const int cx = hd * 64 + p;
    float wbc[4], wx[4];
#pragma unroll
    for (int j = 0; j < 4; ++j) { wbc[j] = conv_w[j * 1536 + cbc]; wx[j] = conv_w[j * 1536 + cx]; }
    const float bbc = conv_b[cbc], bx = conv_b[cx];
    const float A = -__expf(a_log[hd]), dtb = dt_bias[hd], Dk = d_skip[hd];
    float hbc[3] = {0.f, 0.f, 0.f}, hx[3] = {0.f, 0.f, 0.f};
    float st[32];
#pragma unroll
    for (int i = 0; i < 32; ++i) st[i] = 0.f;
    for (int ts = 0; ts < SEQ; ++ts) {
        const size_t row = (size_t)b * SEQ + ts; const bf16_t* pr = proj + row * PROJ_P;
        const float rbc = bf2f(pr[CXS + cbc]);
        const float vbc = silu_f(wbc[0] * hbc[0] + wbc[1] * hbc[1] + wbc[2] * hbc[2] + wbc[3] * rbc + bbc);
        hbc[0] = hbc[1]; hbc[1] = hbc[2]; hbc[2] = rbc;
        if (t < 128) sB[t] = bf2f(f2bf(vbc)); else sC[t - 128] = bf2f(f2bf(vbc));
        const float rx = bf2f(pr[CXS + cx]);
        const float vx = bf2f(f2bf(silu_f(wx[0] * hx[0] + wx[1] * hx[1] + wx[2] * hx[2] + wx[3] * rx + bx)));
        hx[0] = hx[1]; hx[1] = hx[2]; hx[2] = rx;
        const float dr = dtraw[row * 16 + hd] + dtb; const float dt = (dr > 20.f) ? dr : log1pf(__expf(dr));
        const float dec = __expf(dt * A), dtx = dt * vx;
        __syncthreads();
        float y = 0.f;
#pragma unroll
        for (int i = 0; i < 32; ++i) { st[i] = st[i] * dec + dtx * sB[nq * 32 + i]; y += sC[nq * 32 + i] * st[i]; }
        y += __shfl_xor(y, 1); y += __shfl_xor(y, 2);
        const float z = bf2f(pr[CZ + hd * 64 + p]);
        const float yz = (y + Dk * vx) * silu_f(z);
        float q = (nq == 0) ? yz * yz : 0.f; q = wave_sum(q);
        if ((t & 63) == 0) sRed[t >> 6] = q;
        if (nq == 0) Y[row * 2048 + 1024 + hd * 64 + p] = (bf16_t)f2bf(yz);
        __syncthreads();
        if (t == 0) ssq[row * 16 + hd] = sRed[0] + sRed[1] + sRed[2] + sRed[3];
    }
}
__device__ __forceinline__ void slow_swa_unit(int unit, int tid, const bf16_t* projc, const float* sinks, bf16_t* OGb) {
    const int qpos = (unit & 3) * 512 + tid, h = (unit >> 2) & 15, b = unit >> 6, kvh = h >> 3;
    const size_t row = (size_t)b * SEQ + qpos;
    const float slope = exp2f(-0.5f * (float)(h + 1));
    float q[64], o[64];
    { const bf16_t* qp = projc + row * ODD_IN + OQ + h * 64;
#pragma unroll
      for (int i = 0; i < 64; ++i) { q[i] = bf2f(qp[i]); o[i] = 0.f; } }
    float m = sinks[h], l = 1.f;
    const int j0 = (qpos - 127 > 0) ? qpos - 127 : 0;
    for (int j = j0; j <= qpos; ++j) {
        const bf16_t* kp = projc + ((size_t)b * SEQ + j) * ODD_IN + OK_ + kvh * 64; float d = 0.f;
#pragma unroll
        for (int i = 0; i < 64; ++i) d += q[i] * bf2f(kp[i]);
        const float a = d * 0.125f - slope * (float)(qpos - j);
        const float n = fmaxf(m, a), c = __expf(m - n), p = __expf(a - n);
        m = n; l = l * c + p;
        const bf16_t* vp = projc + ((size_t)b * SEQ + j) * ODD_IN + OV + kvh * 64;
#pragma unroll
        for (int i = 0; i < 64; ++i) o[i] = o[i] * c + p * bf2f(vp[i]);
    }
    const float il = 1.f / l; const bf16_t* gp = projc + row * ODD_IN + OG_ + h * 64; bf16_t* op = OGb + row * DM + h * 64;
#pragma unroll
    for (int i = 0; i < 64; ++i) op[i] = (bf16_t)f2bf(o[i] * il * silu_f(bf2f(gp[i])));
}

namespace pg8 {
#define PG8_LAS __attribute__((address_space(3)))
typedef unsigned short bf16_t;
typedef short bf16x8 __attribute__((ext_vector_type(8)));
typedef float f32x4 __attribute__((ext_vector_type(4)));
typedef unsigned u32x4 __attribute__((ext_vector_type(4)));
constexpr int BM = 256, BK = 64, HALF = 128, HTB = HALF * BK * 2  , STAGE_BYTES = 8 * HTB, NXCD = 8, WGM = 8;

__host__ __device__ __forceinline__ int lds_byte(int r, int c) { const int st = (r >> 4) * 2 + (c >> 5), rr = r & 15, cc = c & 31, ob = rr * 64 + cc * 2; return st * 1024 + (ob ^ (((ob >> 9) & 1) << 5)); }
__host__ __device__ __forceinline__ void stage_rc(int b, int& R, int& C) { const int st = b / 1024, sb = b % 1024, swz = sb ^ (((sb >> 9) & 1) << 5); R = (st >> 1) * 16 + swz / 64; C = (st & 1) * 32 + (swz % 64) / 2; }
__host__ __device__ __forceinline__ int perm32(int rho) { const int n = rho >> 4, i = rho & 15; return 8 * (i >> 2) + 4 * n + (i & 3); }

struct Unit { int pm, pn; };
struct Gemm { const bf16_t* A; const bf16_t* Bt; int M, N, K; };

struct StaticOrder {
    int nM, nN, nwg, G, c;
    __host__ __device__ void init(int M, int N, int G_, int c_) { nM = M / BM; nN = N / BM; nwg = nM * nN; G = G_; c = c_; }
    __host__ __device__ bool next(int i, Unit& u) const {
        const long L = (long)i * G + c; if (L >= nwg) return false;
        int wgid = (int)L; { const int q = nwg / NXCD, r = nwg % NXCD, xcd = wgid % NXCD, off = wgid / NXCD; wgid = (xcd < r ? xcd * (q + 1) : r * (q + 1) + (xcd - r) * q) + off; }
        const int nig = WGM * nN, gid = wgid / nig, fm = gid * WGM, gsz = (nM - fm) < WGM ? (nM - fm) : WGM;
        u.pm = fm + ((wgid % nig) % gsz); u.pn = (wgid % nig) / gsz; return true;
    }
    __device__ __forceinline__ void a_ready(const Unit&) const {}
    __device__ __forceinline__ void done(const Unit&) const {}
};


__device__ __forceinline__ unsigned cvt_pk_bf16(float lo, float hi) { unsigned r; asm volatile("v_cvt_pk_bf16_f32 %0, %1, %2" : "=v"(r) : "v"(lo), "v"(hi)); return r; }
struct EpiProjA {
    static constexpr bool PERM = true, AFTER_DRAIN = false;
    bf16_t* proj; float* dt; const float* rstd; int pitch, ntile_bf16;
    __device__ __forceinline__ void operator()(const f32x4 (&acc)[2][2][4][2], const Unit& u, int wr, int wc, int fr, int fq) const {
        const int row0 = u.pm * BM + wr * 64 + fr;
        if (u.pn < ntile_bf16) {
            const int col0 = u.pn * BM + wc * 32 + 8 * fq;
#pragma unroll
            for (int ai = 0; ai < 2; ++ai)
#pragma unroll
                for (int m = 0; m < 4; ++m) { const int row = row0 + ai * HALF + m * 16; const float rs = rstd[row]; bf16_t* rowp = proj + (size_t)row * pitch + col0;
#pragma unroll
                    for (int bj = 0; bj < 2; ++bj) { const f32x4 v0 = acc[ai][bj][m][0] * rs, v1 = acc[ai][bj][m][1] * rs;
                        u32x4 w; w.x = cvt_pk_bf16(v0[0], v0[1]); w.y = cvt_pk_bf16(v0[2], v0[3]); w.z = cvt_pk_bf16(v1[0], v1[1]); w.w = cvt_pk_bf16(v1[2], v1[3]);
                        *(u32x4*)(rowp + bj * HALF) = w; } }
        } else if (wc == 0 && fq < 2) {
#pragma unroll
            for (int ai = 0; ai < 2; ++ai)
#pragma unroll
                for (int m = 0; m < 4; ++m) { const int row = row0 + ai * HALF + m * 16; const float rs = rstd[row]; float* dp = dt + (size_t)row * 16 + 8 * fq;
                    *(f32x4*)dp = acc[ai][0][m][0] * rs; *(f32x4*)(dp + 4) = acc[ai][0][m][1] * rs; }
        }
    }
};
struct EpiRes {
    static constexpr bool PERM = true, AFTER_DRAIN = false;
    const float* xin; float* xout; bf16_t* xb; float* ssq; int ldc;
    __device__ __forceinline__ void operator()(const f32x4 (&acc)[2][2][4][2], const Unit& u, int wr, int wc, int fr, int fq) const {
        const int row0 = u.pm * BM + wr * 64 + fr, col0 = u.pn * BM + wc * 32 + 8 * fq;
#pragma unroll
        for (int ai = 0; ai < 2; ++ai)
#pragma unroll
            for (int m = 0; m < 4; ++m) { const int row = row0 + ai * HALF + m * 16; const size_t off = (size_t)row * ldc + col0; float s = 0.f;
#pragma unroll
                for (int bj = 0; bj < 2; ++bj) { const f32x4 a = *(const f32x4*)(xin + off + bj * HALF), b = *(const f32x4*)(xin + off + bj * HALF + 4);
                    const f32x4 o0 = a + acc[ai][bj][m][0], o1 = b + acc[ai][bj][m][1];
                    *(f32x4*)(xout + off + bj * HALF) = o0; *(f32x4*)(xout + off + bj * HALF + 4) = o1;
                    s += (o0[0] * o0[0] + o0[1] * o0[1]) + (o0[2] * o0[2] + o0[3] * o0[3]) + (o1[0] * o1[0] + o1[1] * o1[1]) + (o1[2] * o1[2] + o1[3] * o1[3]);
                    if (xb) { u32x4 w; w.x = cvt_pk_bf16(o0[0], o0[1]); w.y = cvt_pk_bf16(o0[2], o0[3]); w.z = cvt_pk_bf16(o1[0], o1[1]); w.w = cvt_pk_bf16(o1[2], o1[3]); *(u32x4*)(xb + off + bj * HALF) = w; } }
                if (ssq) { s += __shfl_xor(s, 16); s += __shfl_xor(s, 32); if (fq == 0) ssq[(size_t)row * 16 + u.pn * 4 + wc] = s; }
                if (m & 1) asm volatile("" ::: "memory"); }
    }
};
struct EpiProjC {
    static constexpr bool PERM = true, AFTER_DRAIN = false;
    bf16_t* proj; const float* ssq; const float* bias; int pitch; float inv_n, eps;
    __device__ __forceinline__ void operator()(const f32x4 (&acc)[2][2][4][2], const Unit& u, int wr, int wc, int fr, int fq) const {
        const int row0 = u.pm * BM + wr * 64 + fr, col0 = u.pn * BM + wc * 32 + 8 * fq;
        f32x4 bv[2][2];
#pragma unroll
        for (int bj = 0; bj < 2; ++bj)
#pragma unroll
            for (int n = 0; n < 2; ++n) bv[bj][n] = *(const f32x4*)(bias + col0 + bj * HALF + 4 * n);
#pragma unroll
        for (int ai = 0; ai < 2; ++ai)
#pragma unroll
            for (int m = 0; m < 4; ++m) { const int row = row0 + ai * HALF + m * 16; const f32x4* sp = (const f32x4*)(ssq + (size_t)row * 16);
                const f32x4 p0 = sp[0], p1 = sp[1], p2 = sp[2], p3 = sp[3];
                const float ss = ((p0[0] + p0[1]) + (p0[2] + p0[3])) + ((p1[0] + p1[1]) + (p1[2] + p1[3])) + ((p2[0] + p2[1]) + (p2[2] + p2[3])) + ((p3[0] + p3[1]) + (p3[2] + p3[3]));
                const float rs = 1.0f / sqrtf(ss * inv_n + eps); bf16_t* rowp = proj + (size_t)row * pitch + col0;
#pragma unroll
                for (int bj = 0; bj < 2; ++bj) { const f32x4 v0 = acc[ai][bj][m][0] * rs + bv[bj][0], v1 = acc[ai][bj][m][1] * rs + bv[bj][1];
                    u32x4 w; w.x = cvt_pk_bf16(v0[0], v0[1]); w.y = cvt_pk_bf16(v0[2], v0[3]); w.z = cvt_pk_bf16(v1[0], v1[1]); w.w = cvt_pk_bf16(v1[2], v1[3]);
                    *(u32x4*)(rowp + bj * HALF) = w; }
                if (m & 1) asm volatile("" ::: "memory"); }
    }
};

template <class Epi, class Sched, bool ALIGN_EPI = false, bool SP2 = false>
__device__ __forceinline__ void gemm_phase(PG8_LAS unsigned char* lds, const Gemm g, const Sched& S, const Epi& E) {
    const int tid = threadIdx.x, wid = __builtin_amdgcn_readfirstlane(tid >> 6), lane = tid & 63, wr = wid >> 2, wc = wid & 3, fr = lane & 15, fq = lane >> 4;
    const int K = g.K, nt = K / BK;
    unsigned voffA[2], voffB[2];
#pragma unroll
    for (int i = 0; i < 2; ++i) { int R, C; stage_rc(tid * 16 + i * 8192, R, C); const int Rb = Epi::PERM ? ((R & ~31) + perm32(R & 31)) : R;
        voffA[i] = (unsigned)(R * K + C) * 2u; voffB[i] = (unsigned)(Rb * K + C) * 2u; }
    const size_t kstep = (size_t)(BK * 2);
    const size_t hstep = (size_t)HALF * K * 2;
    const size_t tstep = 2 * hstep;
    const unsigned ldsw = (unsigned)wid * 1024u;
    const int aoff = lds_byte(wr * 64 + fr, fq * 8), boff = lds_byte(wc * 32 + fr, fq * 8);
#define PG8_SA(b, h) (((b) * 2 + (h)) * HTB)
#define PG8_SB(b, h) ((4 + (b) * 2 + (h)) * HTB)
#define PG8_STAGE(bufoff, gbase, voff) do { _Pragma("unroll") for (int _i = 0; _i < 2; ++_i) \
        __builtin_amdgcn_global_load_lds((const unsigned*)((const char*)(gbase) + (voff)[_i]), (PG8_LAS unsigned*)(lds + (bufoff) + ldsw + _i * 8192), 16, 0, 0); } while (0)
#define PG8_LDA(dst, b, h) do { _Pragma("unroll") for (int m = 0; m < 4; ++m) _Pragma("unroll") for (int k = 0; k < 2; ++k) dst[m][k] = *(const PG8_LAS bf16x8*)(lds + PG8_SA(b, h) + aoff + m * 2048 + k * 1024); } while (0)
#define PG8_LDB(dst, b, h) do { _Pragma("unroll") for (int n = 0; n < 2; ++n) _Pragma("unroll") for (int k = 0; k < 2; ++k) dst[n][k] = *(const PG8_LAS bf16x8*)(lds + PG8_SB(b, h) + boff + n * 2048 + k * 1024); } while (0)
#define PG8_MMA(ai, bj, At, Bt) do { __builtin_amdgcn_s_setprio(1); _Pragma("unroll") for (int m = 0; m < 4; ++m) _Pragma("unroll") for (int n = 0; n < 2; ++n) _Pragma("unroll") for (int k = 0; k < 2; ++k) \
        acc[ai][bj][m][n] = __builtin_amdgcn_mfma_f32_16x16x32_bf16(Bt[n][k], At[m][k], acc[ai][bj][m][n], 0, 0, 0); __builtin_amdgcn_s_setprio(0); } while (0)
#define PG8_WAIT_V(n) asm volatile("s_waitcnt vmcnt(" #n ")" ::: "memory")
#define PG8_WAIT_L(n) asm volatile("s_waitcnt lgkmcnt(" #n ")" ::: "memory")
#define PG8_BAR __builtin_amdgcn_s_barrier()
#define PG8_SCHED __builtin_amdgcn_sched_barrier(0)
    Unit cur, nxt; int ui = 0;
    if (!S.next(0, cur)) return;
    f32x4 acc[2][2][4][2];
#pragma unroll
    for (int a = 0; a < 2; ++a)
#pragma unroll
        for (int b = 0; b < 2; ++b)
#pragma unroll
            for (int m = 0; m < 4; ++m)
#pragma unroll
                for (int n = 0; n < 2; ++n) acc[a][b][m][n] = (f32x4){0.f, 0.f, 0.f, 0.f};
    bf16x8 At[4][2], B0[2][2], B1[2][2];
    const char* cA = (const char*)g.A + (size_t)cur.pm * tstep; const char* cB = (const char*)g.Bt + (size_t)cur.pn * tstep;
    S.a_ready(cur);
    if constexpr (SP2) {
        PG8_STAGE(PG8_SB(0, 0), cB, voffB); PG8_STAGE(PG8_SB(0, 1), cB + hstep, voffB); PG8_STAGE(PG8_SA(0, 0), cA, voffA); PG8_STAGE(PG8_SA(0, 1), cA + hstep, voffA);
        if (wr == 1) PG8_BAR;
        PG8_WAIT_V(2); PG8_BAR;
        PG8_STAGE(PG8_SB(1, 0), cB + kstep, voffB); PG8_STAGE(PG8_SA(1, 0), cA + kstep, voffA); PG8_STAGE(PG8_SB(1, 1), cB + hstep + kstep, voffB);
        PG8_WAIT_V(6); PG8_BAR;
    } else {
        PG8_STAGE(PG8_SB(0, 0), cB, voffB); PG8_STAGE(PG8_SA(0, 0), cA, voffA); PG8_STAGE(PG8_SB(0, 1), cB + hstep, voffB); PG8_STAGE(PG8_SA(0, 1), cA + hstep, voffA);
        if (wr == 1) PG8_BAR;
        PG8_WAIT_V(4); PG8_BAR;
        PG8_STAGE(PG8_SB(1, 0), cB + kstep, voffB); PG8_STAGE(PG8_SA(1, 0), cA + kstep, voffA); PG8_STAGE(PG8_SB(1, 1), cB + hstep + kstep, voffB);
        PG8_WAIT_V(6); PG8_BAR;
    }
    for (;;) {
        const bool has_next = S.next(ui + 1, nxt);
        const char* nA = has_next ? (const char*)g.A + (size_t)nxt.pm * tstep : cA; const char* nB = has_next ? (const char*)g.Bt + (size_t)nxt.pn * tstep : cB;
        for (int t = 0; t < nt; t += 2) {
            const bool last = (t == nt - 2);
            const char* a1 = cA + (size_t)(t + 1) * kstep;
            const char* a2 = last ? nA : cA + (size_t)(t + 2) * kstep; const char* b2 = last ? nB : cB + (size_t)(t + 2) * kstep;
            const char* a3 = a2 + kstep; const char* b3 = b2 + kstep;
            if (last && has_next) S.a_ready(nxt);
            if constexpr (SP2) {
            PG8_LDB(B0, 0, 0); PG8_LDB(B1, 0, 1); PG8_SCHED; PG8_LDA(At, 0, 0); PG8_STAGE(PG8_SA(1, 1), a1 + hstep, voffA);
            PG8_WAIT_V(8); PG8_WAIT_L(0); PG8_BAR; PG8_MMA(0, 0, At, B0); PG8_MMA(0, 1, At, B1); PG8_BAR; PG8_SCHED;
            PG8_LDA(At, 0, 1); PG8_STAGE(PG8_SB(0, 0), b2, voffB); PG8_STAGE(PG8_SB(0, 1), b2 + hstep, voffB); PG8_STAGE(PG8_SA(0, 0), a2, voffA);
            PG8_WAIT_V(8); PG8_WAIT_L(0); PG8_BAR; PG8_MMA(1, 0, At, B0); PG8_MMA(1, 1, At, B1); PG8_BAR; PG8_SCHED;
            PG8_LDB(B0, 1, 0); PG8_LDB(B1, 1, 1); PG8_SCHED; PG8_LDA(At, 1, 0); PG8_STAGE(PG8_SA(0, 1), a2 + hstep, voffA);
            PG8_WAIT_V(8); PG8_WAIT_L(0); PG8_BAR; PG8_MMA(0, 0, At, B0); PG8_MMA(0, 1, At, B1); PG8_BAR; PG8_SCHED;
            PG8_LDA(At, 1, 1); PG8_STAGE(PG8_SB(1, 0), b3, voffB); PG8_STAGE(PG8_SB(1, 1), b3 + hstep, voffB); PG8_STAGE(PG8_SA(1, 0), a3, voffA);
            PG8_WAIT_V(8); PG8_WAIT_L(0); PG8_BAR; PG8_MMA(1, 0, At, B0); PG8_MMA(1, 1, At, B1); PG8_BAR; PG8_SCHED;
            } else {
            PG8_LDB(B0, 0, 0); PG8_SCHED; PG8_LDA(At, 0, 0); PG8_STAGE(PG8_SA(1, 1), a1 + hstep, voffA);
            PG8_WAIT_L(8); PG8_BAR; PG8_WAIT_L(0); PG8_MMA(0, 0, At, B0); PG8_BAR; PG8_SCHED;
            PG8_LDB(B1, 0, 1); PG8_STAGE(PG8_SB(0, 0), b2, voffB);
            PG8_BAR; PG8_WAIT_L(0); PG8_MMA(0, 1, At, B1); PG8_BAR;
            PG8_LDA(At, 0, 1); PG8_STAGE(PG8_SA(0, 0), a2, voffA);
            PG8_BAR; PG8_WAIT_L(0); PG8_MMA(1, 0, At, B0); PG8_BAR; PG8_SCHED;
            PG8_STAGE(PG8_SB(0, 1), b2 + hstep, voffB);
            PG8_WAIT_V(6); PG8_BAR; PG8_MMA(1, 1, At, B1); PG8_BAR;
            PG8_LDB(B0, 1, 0); PG8_SCHED; PG8_LDA(At, 1, 0); PG8_STAGE(PG8_SA(0, 1), a2 + hstep, voffA);
            PG8_WAIT_L(8); PG8_BAR; PG8_WAIT_L(0); PG8_MMA(0, 0, At, B0); PG8_BAR; PG8_SCHED;
            PG8_LDB(B1, 1, 1); PG8_STAGE(PG8_SB(1, 0), b3, voffB);
            PG8_BAR; PG8_WAIT_L(0); PG8_MMA(0, 1, At, B1); PG8_BAR;
            PG8_LDA(At, 1, 1); PG8_STAGE(PG8_SA(1, 0), a3, voffA);
            PG8_BAR; PG8_WAIT_L(0); PG8_MMA(1, 0, At, B0); PG8_BAR; PG8_SCHED;
            PG8_STAGE(PG8_SB(1, 1), b3 + hstep, voffB);
            PG8_WAIT_V(6); PG8_BAR; PG8_MMA(1, 1, At, B1); PG8_BAR;
            }
        }
        if constexpr (ALIGN_EPI) { if (wr == 0) PG8_BAR; }
        if constexpr (!Epi::AFTER_DRAIN) { E(acc, cur, wr, wc, fr, fq); S.done(cur); }
        if (!has_next) break;
#pragma unroll
        for (int a = 0; a < 2; ++a)
#pragma unroll
            for (int b = 0; b < 2; ++b)
#pragma unroll
                for (int m = 0; m < 4; ++m)
#pragma unroll
                    for (int n = 0; n < 2; ++n) acc[a][b][m][n] = (f32x4){0.f, 0.f, 0.f, 0.f};
        cur = nxt; cA = nA; cB = nB; ++ui;
        if constexpr (ALIGN_EPI) { if (wr == 1) PG8_BAR; }
    }
    PG8_WAIT_V(0);
    if constexpr (!ALIGN_EPI) { if (wr == 0) PG8_BAR; }
    PG8_BAR;
    if constexpr (Epi::AFTER_DRAIN) { E.fused(acc, cur, wr, wc, fr, fq, lds, wid, lane); S.done(cur); }
#undef PG8_SA
#undef PG8_SB
#undef PG8_STAGE
#undef PG8_LDA
#undef PG8_LDB
#undef PG8_MMA
#undef PG8_WAIT_V
#undef PG8_WAIT_L
#undef PG8_BAR
#undef PG8_SCHED
}
}

typedef short bf16x8 __attribute__((ext_vector_type(8)));
typedef short s16x4 __attribute__((ext_vector_type(4)));
typedef short v4i16_t __attribute__((ext_vector_type(4)));
typedef float f32x16 __attribute__((ext_vector_type(16)));
typedef LAS const char* lds_cptr;
__device__ __forceinline__ int crow(int r, int hi) { return (r & 3) + 8 * (r >> 2) + 4 * hi; }
__device__ __forceinline__ s16x4 vtr(lds_cptr p) { return __builtin_bit_cast(s16x4, __builtin_amdgcn_ds_read_tr16_b64_v4i16((LAS v4i16_t*)p)); }
__device__ __forceinline__ unsigned cvtpk(float lo, float hi) { unsigned r; asm volatile("v_cvt_pk_bf16_f32 %0, %1, %2" : "=v"(r) : "v"(lo), "v"(hi)); return r; }
__device__ __forceinline__ float swap32_max(float v) { auto rr = __builtin_amdgcn_permlane32_swap(__float_as_uint(v), __float_as_uint(v), false, false); return fmaxf(__uint_as_float(rr[0]), __uint_as_float(rr[1])); }
__device__ __forceinline__ float swap32_sum(float v) { auto rr = __builtin_amdgcn_permlane32_swap(__float_as_uint(v), __float_as_uint(v), false, false); return __uint_as_float(rr[0]) + __uint_as_float(rr[1]); }
#define MFMA32(a, b, c) __builtin_amdgcn_mfma_f32_32x32x16_bf16((a), (b), (c), 0, 0, 0)

constexpr int DA_KOFF = 0, DA_VOFF = 16384, DA_BUF = 32768, DA_WS = 65536, DA_DIFF = 69632, DA_DPITCH = 132;
__device__ __forceinline__ void fast_diffattn_unit(int b, int h, int qblk, LAS unsigned char* lds, const bf16_t* proj, float lam, const float* subln, bf16_t* Y, int ypitch) {
    const int tid = threadIdx.x, lane = tid & 63, wave = __builtin_amdgcn_readfirstlane(tid >> 6), r32 = lane & 31, hh = lane >> 5, mp = wave >> 2, qs = wave & 3;
    const int q0 = qblk * 128 + qs * 32;
    const size_t rowbase = (size_t)b * SEQ;
    bf16x8 qf[4];
#pragma unroll
    for (int ds = 0; ds < 4; ++ds) qf[ds] = *(const bf16x8*)(proj + (rowbase + q0 + r32) * PROJ_P + CQ + h * 128 + mp * 64 + ds * 16 + hh * 8);
    const float slope2 = exp2f(-(float)(h + 1)) * LOG2E, sc2 = 0.125f * LOG2E;
    f32x16 o[4];
#pragma unroll
    for (int d = 0; d < 4; ++d)
#pragma unroll
        for (int r = 0; r < 16; ++r) o[d][r] = 0.f;
    float m = -1e30f, l = 0.f;
    LAS float* wsf = (LAS float*)(lds + DA_WS) + wave * 64;
    const int T = 2 * (qblk + 1);
    const bf16_t* ksrc = proj + (rowbase + lane) * PROJ_P + CK + h * 128 + wave * 8;
    const bf16_t* vsrc = proj + (rowbase + 16 * (wave & 3) + (lane >> 2)) * PROJ_P + CV + h * 128 + (wave >> 2) * 32 + (lane & 3) * 8;
    const int kdst = DA_KOFF + wave * 1024 + lane * 16, vdst = DA_VOFF + wave * 1024 + lane * 16;
    u32x4 kr[2], vr[2];
#define DA_LOAD(t) do { const size_t to_ = (size_t)(t) * 64 * PROJ_P; kr[0] = *(const u32x4*)(ksrc + to_); kr[1] = *(const u32x4*)(ksrc + to_ + 64); vr[0] = *(const u32x4*)(vsrc + to_); vr[1] = *(const u32x4*)(vsrc + to_ + 64); } while (0)
#define DA_WRITE(bo) do { *(LAS u32x4*)(lds + (bo) + kdst) = kr[0]; *(LAS u32x4*)(lds + (bo) + kdst + 8192) = kr[1]; *(LAS u32x4*)(lds + (bo) + vdst) = vr[0]; *(LAS u32x4*)(lds + (bo) + vdst + 8192) = vr[1]; } while (0)
    DA_LOAD(T - 1); DA_WRITE(0);
    __syncthreads();
    const int kfo = (8 * mp + hh) * 1024 + r32 * 16;
    const int vfo = DA_VOFF + ((lane >> 4) & 1) * 32 + (lane & 3) * 8 + (4 * hh + ((lane & 15) >> 2)) * 64;
    for (int it = 0; it < T; ++it) {
        const int t = T - 1 - it, bo = (it & 1) * DA_BUF;
        if (it + 1 < T) DA_LOAD(t - 1);
        if (64 * t <= q0 + 31) {
            lds_cptr kb = (lds_cptr)(lds + bo + kfo);
            f32x16 s0, s1;
#pragma unroll
            for (int r = 0; r < 16; ++r) { s0[r] = 0.f; s1[r] = 0.f; }
#pragma unroll
            for (int ds = 0; ds < 4; ++ds) {
                const bf16x8 a0 = *(const LAS bf16x8*)(kb + ds * 2048), a1 = *(const LAS bf16x8*)(kb + ds * 2048 + 512);
                s0 = MFMA32(a0, qf[ds], s0); s1 = MFMA32(a1, qf[ds], s1);
            }
            const float tb = slope2 * (float)(64 * t + 4 * hh - q0);
#pragma unroll
            for (int r = 0; r < 16; ++r) { const float c = slope2 * (float)((r & 3) + 8 * (r >> 2)) + tb; s0[r] = s0[r] * sc2 + c; s1[r] = s1[r] * sc2 + (c + 32.f * slope2); }
            if (64 * t + 63 > q0) {
                const int qrel = q0 + r32 - 64 * t - 4 * hh;
#pragma unroll
                for (int r = 0; r < 16; ++r) { const int kv = (r & 3) + 8 * (r >> 2); if (kv > qrel) s0[r] = -INFINITY; if (kv + 32 > qrel) s1[r] = -INFINITY; }
            }
            float mx = fmaxf(s0[0], s1[0]);
#pragma unroll
            for (int r = 1; r < 16; ++r) mx = fmaxf(mx, fmaxf(s0[r], s1[r]));
            mx = swap32_max(mx);
            if (__any(mx > m + 8.f)) {
                const float mn = fmaxf(m, mx), al = __builtin_amdgcn_exp2f(m - mn);
                m = mn; l *= al;
                if (hh == 0) wsf[r32] = al;
#pragma unroll
                for (int r = 0; r < 16; ++r) { const float ar = wsf[crow(r, hh)];
#pragma unroll
                    for (int d = 0; d < 4; ++d) o[d][r] *= ar; }
            }
            float ps = 0.f;
#pragma unroll
            for (int r = 0; r < 16; ++r) { s0[r] = __builtin_amdgcn_exp2f(s0[r] - m); s1[r] = __builtin_amdgcn_exp2f(s1[r] - m); ps += s0[r] + s1[r]; }
            l += ps;
            u32x4 pw[4];
#pragma unroll
            for (int k = 0; k < 2; ++k)
#pragma unroll
                for (int j = 0; j < 4; ++j) { pw[k][j] = cvtpk(s0[8 * k + 2 * j], s0[8 * k + 2 * j + 1]); pw[2 + k][j] = cvtpk(s1[8 * k + 2 * j], s1[8 * k + 2 * j + 1]); }
            lds_cptr vb = (lds_cptr)(lds + bo + vfo);
#pragma unroll
            for (int d = 0; d < 4; ++d)
#pragma unroll
                for (int ks = 0; ks < 4; ++ks) {
                    const s16x4 lo = vtr(vb + d * 4096 + ks * 1024), hi = vtr(vb + d * 4096 + ks * 1024 + 512);
                    const bf16x8 vf = (bf16x8){lo[0], lo[1], lo[2], lo[3], hi[0], hi[1], hi[2], hi[3]};
                    o[d] = MFMA32(__builtin_bit_cast(bf16x8, pw[ks]), vf, o[d]);
                }
        }
        if (it + 1 < T) DA_WRITE(((it + 1) & 1) * DA_BUF);
        __syncthreads();
    }
#undef DA_LOAD
#undef DA_WRITE
    l = swap32_sum(l);
    if (hh == 0) wsf[r32] = 1.f / l;
    float inv[16];
#pragma unroll
    for (int r = 0; r < 16; ++r) inv[r] = wsf[crow(r, hh)];
    LAS float* exch = (LAS float*)lds + qs * 4096;
    if (mp == 1) {
#pragma unroll
        for (int d = 0; d < 4; ++d)
#pragma unroll
            for (int r = 0; r < 16; ++r) exch[(d * 16 + r) * 64 + lane] = o[d][r] * inv[r] * lam;
    }
    __syncthreads();
    LAS float* dimg = (LAS float*)(lds + DA_DIFF);
    if (mp == 0) {
#pragma unroll
        for (int d = 0; d < 4; ++d)
#pragma unroll
            for (int r = 0; r < 16; ++r) dimg[(qs * 32 + crow(r, hh)) * DA_DPITCH + d * 32 + r32] = o[d][r] * inv[r] - exch[(d * 16 + r) * 64 + lane];
    }
    __syncthreads();
    {
        const int row = tid >> 2, qt = tid & 3; const size_t grow = rowbase + qblk * 128 + row;
        f32x4 dv[8]; float ss = 0.f;
#pragma unroll
        for (int i = 0; i < 8; ++i) { dv[i] = *(const LAS f32x4*)(dimg + row * DA_DPITCH + qt * 32 + 4 * i); ss += (dv[i][0] * dv[i][0] + dv[i][1] * dv[i][1]) + (dv[i][2] * dv[i][2] + dv[i][3] * dv[i][3]); }
        ss += __shfl_xor(ss, 1); ss += __shfl_xor(ss, 2);
        const float rn = (1.f - LAMBDA_INIT) / sqrtf(ss * (1.f / 128.f) + EPS);
        const u32x4* gp = (const u32x4*)(proj + grow * PROJ_P + CGA + h * 128 + qt * 32); u32x4* yp = (u32x4*)(Y + grow * ypitch + h * 128 + qt * 32);
        const f32x4* wp = (const f32x4*)(subln + qt * 32);
#pragma unroll
        for (int i = 0; i < 4; ++i) { const u32x4 g = gp[i]; const f32x4 w0 = wp[2 * i], w1 = wp[2 * i + 1], d0 = dv[2 * i], d1 = dv[2 * i + 1]; u32x4 y;
            y.x = pk2(d0[0] * rn * w0[0] * silu_f(bf2f(g.x & 0xffffu)), d0[1] * rn * w0[1] * silu_f(bf2f(g.x >> 16)));
            y.y = pk2(d0[2] * rn * w0[2] * silu_f(bf2f(g.y & 0xffffu)), d0[3] * rn * w0[3] * silu_f(bf2f(g.y >> 16)));
            y.z = pk2(d1[0] * rn * w1[0] * silu_f(bf2f(g.z & 0xffffu)), d1[1] * rn * w1[1] * silu_f(bf2f(g.z >> 16)));
            y.w = pk2(d1[2] * rn * w1[2] * silu_f(bf2f(g.w & 0xffffu)), d1[3] * rn * w1[3] * silu_f(bf2f(g.w >> 16)));
            yp[i] = y; }
    }
    __syncthreads();
}

constexpr int SW_TILE = 16384, SW_BUF = 3 * SW_TILE, SW_WS = 2 * SW_BUF, SW_STG = SW_WS + 2048, SW_SPITCH = 36;
__device__ __forceinline__ void fast_swa_group(int ug, LAS unsigned char* lds, const bf16_t* projc, const float* sinks, bf16_t* OGb, int opitch) {
    const int tid = threadIdx.x, lane = tid & 63, wave = __builtin_amdgcn_readfirstlane(tid >> 6), r32 = lane & 31, hh = lane >> 5;
    LAS float* wsf = (LAS float*)(lds + SW_WS) + wave * 64;
    LAS float* stg = (LAS float*)(lds + SW_STG) + wave * (32 * SW_SPITCH);
    const int kdst = wave * 1024 + lane * 16, vdst = 8192 + wave * 1024 + lane * 16;
    const int vfo = 8192 + ((lane >> 4) & 1) * 32 + (lane & 3) * 8 + (4 * hh + ((lane & 15) >> 2)) * 64;
    u32x4 kr[3], vr[3];
#define SW_DECODE(u, b_, kvh_, q0_, thi_, nt_) const int b_ = (u) >> 7, kvh_ = ((u) >> 6) & 1, q0_ = ((u) & 63) * 32, thi_ = (q0_ + 31) >> 6, nt_ = thi_ - ((q0_ >= 127) ? ((q0_ - 127) >> 6) : 0) + 1
#define SW_LOAD(u) do { SW_DECODE(u, b_, kvh_, q0_, thi_, nt_); (void)q0_; \
        const bf16_t* ks_ = projc + ((size_t)b_ * SEQ + lane) * ODD_IN + OK_ + kvh_ * 64 + wave * 8; \
        const bf16_t* vs_ = projc + ((size_t)b_ * SEQ + 16 * (wave & 3) + (lane >> 2)) * ODD_IN + OV + kvh_ * 64 + (wave >> 2) * 32 + (lane & 3) * 8; \
        _Pragma("unroll") for (int s_ = 0; s_ < 3; ++s_) if (s_ < nt_) { const size_t to_ = (size_t)(thi_ - s_) * 64 * ODD_IN; kr[s_] = *(const u32x4*)(ks_ + to_); vr[s_] = *(const u32x4*)(vs_ + to_); } } while (0)
#define SW_WRITE(u, bo) do { SW_DECODE(u, b_, kvh_, q0_, thi_, nt_); (void)b_; (void)kvh_; (void)q0_; \
        _Pragma("unroll") for (int s_ = 0; s_ < 3; ++s_) if (s_ < nt_) { *(LAS u32x4*)(lds + (bo) + s_ * SW_TILE + kdst) = kr[s_]; *(LAS u32x4*)(lds + (bo) + s_ * SW_TILE + vdst) = vr[s_]; } } while (0)
    const int u0 = ug * 8;
    SW_LOAD(u0); SW_WRITE(u0, 0);
    __syncthreads();
    for (int i = 0; i < 8; ++i) {
        const int u = u0 + i, bo = (i & 1) * SW_BUF;
        if (i + 1 < 8) SW_LOAD(u + 1);
        {
            SW_DECODE(u, b, kvh, q0, thi, nt);
            const int head = kvh * 8 + wave; const size_t rowbase = (size_t)b * SEQ;
            bf16x8 qf[4];
#pragma unroll
            for (int ds = 0; ds < 4; ++ds) qf[ds] = *(const bf16x8*)(projc + (rowbase + q0 + r32) * ODD_IN + OQ + head * 64 + ds * 16 + hh * 8);
            const float slope2 = exp2f(-0.5f * (float)(head + 1)) * LOG2E, sc2 = 0.125f * LOG2E;
            float m = sinks[head] * LOG2E + slope2 * (float)r32, l = (hh == 0) ? 1.f : 0.f;
            f32x16 o[2];
#pragma unroll
            for (int d = 0; d < 2; ++d)
#pragma unroll
                for (int r = 0; r < 16; ++r) o[d][r] = 0.f;
            for (int s = 0; s < nt; ++s) {
                const int t = thi - s;
                lds_cptr kb = (lds_cptr)(lds + bo + s * SW_TILE + hh * 1024 + r32 * 16);
                f32x16 s0, s1;
#pragma unroll
                for (int r = 0; r < 16; ++r) { s0[r] = 0.f; s1[r] = 0.f; }
#pragma unroll
                for (int ds = 0; ds < 4; ++ds) {
                    const bf16x8 a0 = *(const LAS bf16x8*)(kb + ds * 2048), a1 = *(const LAS bf16x8*)(kb + ds * 2048 + 512);
                    s0 = MFMA32(a0, qf[ds], s0); s1 = MFMA32(a1, qf[ds], s1);
                }
                const float tb = slope2 * (float)(64 * t + 4 * hh - q0);
                const int qrel = q0 + r32 - 64 * t - 4 * hh;
#pragma unroll
                for (int r = 0; r < 16; ++r) { const int kv = (r & 3) + 8 * (r >> 2); const float c = slope2 * (float)kv + tb;
                    s0[r] = (kv > qrel || kv < qrel - 127) ? -INFINITY : s0[r] * sc2 + c;
                    s1[r] = (kv + 32 > qrel || kv + 32 < qrel - 127) ? -INFINITY : s1[r] * sc2 + (c + 32.f * slope2); }
                float mx = fmaxf(s0[0], s1[0]);
#pragma unroll
                for (int r = 1; r < 16; ++r) mx = fmaxf(mx, fmaxf(s0[r], s1[r]));
                mx = swap32_max(mx);
                if (__any(mx > m + 8.f)) {
                    const float mn = fmaxf(m, mx), al = __builtin_amdgcn_exp2f(m - mn);
                    m = mn; l *= al;
                    if (hh == 0) wsf[r32] = al;
#pragma unroll
                    for (int r = 0; r < 16; ++r) { const float ar = wsf[crow(r, hh)]; o[0][r] *= ar; o[1][r] *= ar; }
                }
                float ps = 0.f;
#pragma unroll
                for (int r = 0; r < 16; ++r) { s0[r] = __builtin_amdgcn_exp2f(s0[r] - m); s1[r] = __builtin_amdgcn_exp2f(s1[r] - m); ps += s0[r] + s1[r]; }
                l += ps;
                u32x4 pw[4];
#pragma unroll
                for (int k = 0; k < 2; ++k)
#pragma unroll
                    for (int j = 0; j < 4; ++j) { pw[k][j] = cvtpk(s0[8 * k + 2 * j], s0[8 * k + 2 * j + 1]); pw[2 + k][j] = cvtpk(s1[8 * k + 2 * j], s1[8 * k + 2 * j + 1]); }
                lds_cptr vb = (lds_cptr)(lds + bo + s * SW_TILE + vfo);
#pragma unroll
                for (int d = 0; d < 2; ++d)
#pragma unroll
                    for (int ks = 0; ks < 4; ++ks) {
                        const s16x4 lo = vtr(vb + d * 4096 + ks * 1024), hi = vtr(vb + d * 4096 + ks * 1024 + 512);
                        const bf16x8 vf = (bf16x8){lo[0], lo[1], lo[2], lo[3], hi[0], hi[1], hi[2], hi[3]};
                        o[d] = MFMA32(__builtin_bit_cast(bf16x8, pw[ks]), vf, o[d]);
                    }
            }
            l = swap32_sum(l);
            if (hh == 0) wsf[r32] = 1.f / l;
            float inv[16];
#pragma unroll
            for (int r = 0; r < 16; ++r) inv[r] = wsf[crow(r, hh)];
            const int row = lane >> 1, hf = lane & 1; const size_t grow = rowbase + q0 + row;
#pragma unroll
            for (int d = 0; d < 2; ++d) {
#pragma unroll
                for (int r = 0; r < 16; ++r) stg[crow(r, hh) * SW_SPITCH + r32] = o[d][r] * inv[r];
                const u32x4* gp = (const u32x4*)(projc + grow * ODD_IN + OG_ + head * 64 + d * 32 + hf * 16); u32x4* op = (u32x4*)(OGb + grow * opitch + head * 64 + d * 32 + hf * 16);
#pragma unroll
                for (int i = 0; i < 2; ++i) { const u32x4 g = gp[i]; const f32x4 a0 = *(const LAS f32x4*)(stg + row * SW_SPITCH + hf * 16 + 8 * i), a1 = *(const LAS f32x4*)(stg + row * SW_SPITCH + hf * 16 + 8 * i + 4); u32x4 y;
                    y.x = pk2(a0[0] * silu_f(bf2f(g.x & 0xffffu)), a0[1] * silu_f(bf2f(g.x >> 16))); y.y = pk2(a0[2] * silu_f(bf2f(g.y & 0xffffu)), a0[3] * silu_f(bf2f(g.y >> 16)));
                    y.z = pk2(a1[0] * silu_f(bf2f(g.z & 0xffffu)), a1[1] * silu_f(bf2f(g.z >> 16))); y.w = pk2(a1[2] * silu_f(bf2f(g.w & 0xffffu)), a1[3] * silu_f(bf2f(g.w >> 16)));
                    op[i] = y; }
            }
        }
        if (i + 1 < 8) SW_WRITE(u + 1, ((i + 1) & 1) * SW_BUF);
        __syncthreads();
    }
#undef SW_DECODE
#undef SW_LOAD
#undef SW_WRITE
}

constexpr int SS_BM = 0, SS_CM = 32768, SS_XDT = 65536, SS_XW = 81920, SS_H = 98304, SS_ZT = 114688, SS_ZP = 144, SS_F = 133120;
__device__ __forceinline__ int rowoff_a(int row) { return 2048 * (row >> 3) + 64 * (row & 7); }
__device__ __forceinline__ int off_a(int row, int ch) { return rowoff_a(row) + 512 * (ch >> 2) + 16 * ((ch & 3) ^ ((row >> 2) & 3)); }
__device__ __forceinline__ void fast_ssd_unit(int b, int hd, LAS unsigned char* lds, const bf16_t* proj, const float* dtraw, const float* conv_w, const float* conv_b, const float* dt_bias, const float* a_log,
                                              const float* d_skip, bf16_t* Y, int ypitch, int ycol0, float* ssq) {
    const int tid = threadIdx.x, lane = tid & 63, wave = __builtin_amdgcn_readfirstlane(tid >> 6), r32 = lane & 31, hh = lane >> 5, lb = wave & 3, pb = wave >> 2, g = hd >> 3;
    const size_t rowbase = (size_t)b * SEQ;
    LAS float* fdt = (LAS float*)(lds + SS_F); LAS float* fcs = fdt + 128; LAS float* fecs = fdt + 256;
    const float A2 = -__expf(a_log[hd]) * LOG2E, dtb = dt_bias[hd], Dk = d_skip[hd];
    f32x16 Hacc;
#pragma unroll
    for (int r = 0; r < 16; ++r) Hacc[r] = 0.f;
    const int blk = (lane >> 4) & 1, q4 = (lane & 15) >> 2, p4 = lane & 3;
    const int xr = (r32 >> 2) & 3, rr0 = rowoff_a(r32) + 16 * (hh ^ xr), rr1 = rowoff_a(r32) + 16 * ((hh ^ xr) ^ 2);
    const int tb0 = 2048 * hh + 512 * lb + 64 * q4 + 16 * ((2 * blk + (p4 >> 1)) ^ ((2 * hh) & 3)) + 8 * (p4 & 1);
    const int tb1 = 2048 * hh + 512 * lb + 64 * (4 + q4) + 16 * ((2 * blk + (p4 >> 1)) ^ ((2 * hh + 1) & 3)) + 8 * (p4 & 1);
    const int vfo = blk * 32 + p4 * 8 + (4 * hh + q4) * 64;
    const int vfn = blk * 32 + p4 * 8 + (8 * hh + q4) * 64;
    for (int c = 0; c < 16; ++c) {
        const size_t crow0 = rowbase + (size_t)c * 128;
        if (wave == 0) {
            const float r0 = dtraw[(crow0 + 2 * lane) * 16 + hd] + dtb, r1 = dtraw[(crow0 + 2 * lane + 1) * 16 + hd] + dtb;
            const float d0 = (r0 > 20.f) ? r0 : log1pf(__expf(r0)), d1 = (r1 > 20.f) ? r1 : log1pf(__expf(r1));
            const float a0 = d0 * A2, a1 = d1 * A2; float s = a0 + a1;
#pragma unroll
            for (int o = 1; o < 64; o <<= 1) { const float t = __shfl_up(s, o); if (lane >= o) s += t; }
            const float c1 = s, c0 = s - a1;
            fdt[2 * lane] = d0; fdt[2 * lane + 1] = d1; fcs[2 * lane] = c0; fcs[2 * lane + 1] = c1; fecs[2 * lane] = __builtin_amdgcn_exp2f(c0); fecs[2 * lane + 1] = __builtin_amdgcn_exp2f(c1);
        }
        {
            const bf16_t* zs = proj + (crow0 + (tid >> 3)) * PROJ_P + CZ + hd * 64 + (tid & 7) * 8;
            const u32x4 z0 = *(const u32x4*)zs, z1 = *(const u32x4*)(zs + (size_t)64 * PROJ_P);
            *(LAS u32x4*)(lds + SS_ZT + (tid >> 3) * SS_ZP + (tid & 7) * 16) = z0; *(LAS u32x4*)(lds + SS_ZT + ((tid >> 3) + 64) * SS_ZP + (tid & 7) * 16) = z1;
        }
        {
            const int half = tid >> 8, t = tid & 255, cc = t & 15, run = t >> 4;
            const int ch = 1024 + half * 256 + g * 128 + cc * 8;
            const bf16_t* src = proj + (crow0 + 8 * run) * PROJ_P + CXS + ch;
            f32x4 w[4][2], bs[2];
#pragma unroll
            for (int j = 0; j < 4; ++j) { w[j][0] = *(const f32x4*)(conv_w + j * 1536 + ch); w[j][1] = *(const f32x4*)(conv_w + j * 1536 + ch + 4); }
            bs[0] = *(const f32x4*)(conv_b + ch); bs[1] = *(const f32x4*)(conv_b + ch + 4);
            u32x4 raw[11];
#pragma unroll
            for (int i = 0; i < 11; ++i) { const bool ok = (c > 0) || (8 * run + i >= 3); raw[i] = ok ? *(const u32x4*)(src + (ptrdiff_t)(i - 3) * PROJ_P) : (u32x4){0u, 0u, 0u, 0u}; }
            LAS unsigned char* img = lds + (half ? SS_CM : SS_BM) + 2048 * run + 512 * (cc >> 2);
#pragma unroll
            for (int r = 0; r < 8; ++r) {
                float v[8];
#pragma unroll
                for (int e = 0; e < 8; ++e) v[e] = bs[e >> 2][e & 3];
#pragma unroll
                for (int j = 0; j < 4; ++j)
#pragma unroll
                    for (int e = 0; e < 4; ++e) { const unsigned wd = raw[r + j][e]; v[2 * e] += w[j][(2 * e) >> 2][(2 * e) & 3] * bf2f(wd & 0xffffu); v[2 * e + 1] += w[j][(2 * e + 1) >> 2][(2 * e + 1) & 3] * bf2f(wd >> 16); }
                u32x4 o;
#pragma unroll
                for (int e = 0; e < 4; ++e) o[e] = pk2(silu_f(v[2 * e]), silu_f(v[2 * e + 1]));
                *(LAS u32x4*)(img + 64 * r + 16 * ((cc & 3) ^ ((2 * run + (r >> 2)) & 3))) = o;
            }
        }
        __syncthreads();
        {
            const int cc = tid & 7, rr = tid >> 3, ch = hd * 64 + cc * 8;
            const bf16_t* src = proj + (crow0 + 2 * rr) * PROJ_P + CXS + ch;
            u32x4 raw[5];
#pragma unroll
            for (int i = 0; i < 5; ++i) { const bool ok = (c > 0) || (2 * rr + i >= 3); raw[i] = ok ? *(const u32x4*)(src + (ptrdiff_t)(i - 3) * PROJ_P) : (u32x4){0u, 0u, 0u, 0u}; }
            f32x4 w[4][2], bs[2];
#pragma unroll
            for (int j = 0; j < 4; ++j) { w[j][0] = *(const f32x4*)(conv_w + j * 1536 + ch); w[j][1] = *(const f32x4*)(conv_w + j * 1536 + ch + 4); }
            bs[0] = *(const f32x4*)(conv_b + ch); bs[1] = *(const f32x4*)(conv_b + ch + 4);
            const float cl = fcs[127];
#pragma unroll
            for (int r = 0; r < 2; ++r) {
                const int row = 2 * rr + r; const float dtv = fdt[row], dec = __builtin_amdgcn_exp2f(cl - fcs[row]);
                float v[8];
#pragma unroll
                for (int e = 0; e < 8; ++e) v[e] = bs[e >> 2][e & 3];
#pragma unroll
                for (int j = 0; j < 4; ++j)
#pragma unroll
                    for (int e = 0; e < 4; ++e) { const unsigned wd = raw[r + j][e]; v[2 * e] += w[j][(2 * e) >> 2][(2 * e) & 3] * bf2f(wd & 0xffffu); v[2 * e + 1] += w[j][(2 * e + 1) >> 2][(2 * e + 1) & 3] * bf2f(wd >> 16); }
                u32x4 o1, o2;
#pragma unroll
                for (int e = 0; e < 4; ++e) { const float x0 = bf2f(f2bf(silu_f(v[2 * e]))) * dtv, x1 = bf2f(f2bf(silu_f(v[2 * e + 1]))) * dtv; o1[e] = pk2(x0, x1); o2[e] = pk2(x0 * dec, x1 * dec); }
                const int po = ((cc >> 2) * 8 + (row >> 4)) * 1024 + (row & 15) * 64 + (cc & 3) * 16;
                *(LAS u32x4*)(lds + SS_XDT + po) = o1; *(LAS u32x4*)(lds + SS_XW + po) = o2;
            }
        }
        __syncthreads();
        {
            const float csl = fcs[32 * lb + r32];
            f32x16 yacc;
#pragma unroll
            for (int r = 0; r < 16; ++r) yacc[r] = 0.f;
            lds_cptr cfr0 = (lds_cptr)(lds + SS_CM + 8192 * lb + rr0), cfr1 = (lds_cptr)(lds + SS_CM + 8192 * lb + rr1);
            for (int sb = 0; sb <= lb; ++sb) {
                f32x16 X;
#pragma unroll
                for (int r = 0; r < 16; ++r) X[r] = 0.f;
                lds_cptr bfr0 = (lds_cptr)(lds + SS_BM + 8192 * sb + rr0), bfr1 = (lds_cptr)(lds + SS_BM + 8192 * sb + rr1);
#pragma unroll
                for (int ks = 0; ks < 8; ++ks) {
                    const bf16x8 af = *(const LAS bf16x8*)(((ks & 1) ? bfr1 : bfr0) + 512 * (ks >> 1)), bq = *(const LAS bf16x8*)(((ks & 1) ? cfr1 : cfr0) + 512 * (ks >> 1));
                    X = MFMA32(af, bq, X);
                }
                LAS const float* csb = fcs + 32 * sb + 4 * hh;
#pragma unroll
                for (int r = 0; r < 16; ++r) { const int si = (r & 3) + 8 * (r >> 2); const bool dead = (sb == lb) && (si + 4 * hh > r32); const float e = dead ? 0.f : __builtin_amdgcn_exp2f(csl - csb[si]); X[r] *= e; }
#pragma unroll
                for (int k2 = 0; k2 < 2; ++k2) {
                    u32x4 pw;
#pragma unroll
                    for (int j = 0; j < 4; ++j) pw[j] = cvtpk(X[8 * k2 + 2 * j], X[8 * k2 + 2 * j + 1]);
                    lds_cptr vb = (lds_cptr)(lds + SS_XDT + (pb * 8 + 2 * sb + k2) * 1024 + vfo);
                    const s16x4 lo = vtr(vb), hi = vtr(vb + 512);
                    const bf16x8 vf = (bf16x8){lo[0], lo[1], lo[2], lo[3], hi[0], hi[1], hi[2], hi[3]};
                    yacc = MFMA32(__builtin_bit_cast(bf16x8, pw), vf, yacc);
                }
            }
            if (c > 0) {
                f32x16 yo;
#pragma unroll
                for (int r = 0; r < 16; ++r) yo[r] = 0.f;
                lds_cptr hfr0 = (lds_cptr)(lds + SS_H + 8192 * pb + rr0), hfr1 = (lds_cptr)(lds + SS_H + 8192 * pb + rr1);
#pragma unroll
                for (int ks = 0; ks < 8; ++ks) {
                    const bf16x8 af = *(const LAS bf16x8*)(((ks & 1) ? cfr1 : cfr0) + 512 * (ks >> 1)), bq = *(const LAS bf16x8*)(((ks & 1) ? hfr1 : hfr0) + 512 * (ks >> 1));
                    yo = MFMA32(af, bq, yo);
                }
                LAS const float* eb = fecs + 32 * lb + 4 * hh;
#pragma unroll
                for (int r = 0; r < 16; ++r) yacc[r] += eb[(r & 3) + 8 * (r >> 2)] * yo[r];
            }
            {
                LAS const float* db_ = fdt + 32 * lb + 4 * hh;
                LAS unsigned char* zt = lds + SS_ZT + (32 * lb + 4 * hh) * SS_ZP + (32 * pb + r32) * 2;
                lds_cptr xe = (lds_cptr)(lds + SS_XDT + (pb * 8 + 2 * lb) * 1024 + (4 * hh) * 64 + r32 * 2);
#pragma unroll
                for (int r = 0; r < 16; ++r) {
                    const int si = (r & 3) + 8 * (r >> 2);
                    const float xdtv = bf2f(*(const LAS unsigned short*)(xe + (si >> 4) * 1024 + (si & 15) * 64));
                    const float y = yacc[r] + (Dk / db_[si]) * xdtv;
                    const float z = bf2f(*(const LAS unsigned short*)(zt + si * SS_ZP));
                    *(LAS unsigned short*)(zt + si * SS_ZP) = (unsigned short)f2bf(y * silu_f(z));
                }
            }
            if (c < 15) {
                const float dl = fecs[127];
#pragma unroll
                for (int r = 0; r < 16; ++r) Hacc[r] *= dl;
                lds_cptr xa = (lds_cptr)(lds + SS_XW + pb * 8192 + vfn), b0 = (lds_cptr)(lds + SS_BM + tb0), b1 = (lds_cptr)(lds + SS_BM + tb1);
#pragma unroll
                for (int ks = 0; ks < 8; ++ks) {
                    const s16x4 alo = vtr(xa + ks * 1024), ahi = vtr(xa + ks * 1024 + 256);
                    const s16x4 blo = vtr(b0 + ks * 4096), bhi = vtr(b1 + ks * 4096);
                    const bf16x8 af = (bf16x8){alo[0], alo[1], alo[2], alo[3], ahi[0], ahi[1], ahi[2], ahi[3]}, bq = (bf16x8){blo[0], blo[1], blo[2], blo[3], bhi[0], bhi[1], bhi[2], bhi[3]};
                    Hacc = MFMA32(af, bq, Hacc);
                }
            }
        }
        __syncthreads();
        if (c < 15) {
            LAS unsigned char* hb = lds + SS_H + 8192 * pb + 512 * lb + 2048 * 0 + (r32 & 7) * 2;
#pragma unroll
            for (int r = 0; r < 16; ++r) { const int p = crow(r, hh); *(LAS unsigned short*)(hb + rowoff_a(p) + 16 * (((r32 >> 3) & 3) ^ ((p >> 2) & 3))) = (unsigned short)f2bf(Hacc[r]); }
        }
        {
            const int row = tid >> 2, qt = tid & 3;
            const u32x4 y0 = *(const LAS u32x4*)(lds + SS_ZT + row * SS_ZP + qt * 32), y1 = *(const LAS u32x4*)(lds + SS_ZT + row * SS_ZP + qt * 32 + 16);
            float s = 0.f;
#pragma unroll
            for (int e = 0; e < 4; ++e) { const float a0 = bf2f(y0[e] & 0xffffu), a1 = bf2f(y0[e] >> 16), a2 = bf2f(y1[e] & 0xffffu), a3 = bf2f(y1[e] >> 16); s += (a0 * a0 + a1 * a1) + (a2 * a2 + a3 * a3); }
            s += __shfl_xor(s, 1); s += __shfl_xor(s, 2);
            u32x4* yp = (u32x4*)(Y + (crow0 + row) * ypitch + ycol0 + hd * 64 + qt * 16); yp[0] = y0; yp[1] = y1;
            if (qt == 0) ssq[(crow0 + row) * 16 + hd] = s;
        }
        __syncthreads();
    }
}

#include <hip/hip_cooperative_groups.h>
namespace cg = cooperative_groups;
#define GAS __attribute__((address_space(1)))
#define LDS_WAIT() asm volatile("s_waitcnt lgkmcnt(0)" ::: "memory")
constexpr int NWAVES = 8, NTHREADS = NWAVES * 64;
constexpr int RING_BYTES = 131072, LDS_BYTES = 147456;
constexpr int NPHASE = 9;

struct Args { const float* in[21]; float* out; unsigned char* ws; unsigned char* alt; unsigned char* alt2; int ph_lo, ph_hi, fast, altpitch, skip, pad; };

__device__ __forceinline__ void p0_transpose_item(const float* W, const float* s, int K, int N, bf16_t* WT, LAS float* scr, int item, int nblk, int lane) {
    const int kb = item / nblk, nb = item % nblk, k0 = 64 * kb, n0 = 32 * nb, n = n0 + (lane & 31);
    const bool ok = n < N;
#pragma unroll 8
    for (int i = 0; i < 32; ++i) { const int kk = 2 * i + (lane >> 5); float v = ok ? W[(size_t)(k0 + kk) * N + n] : 0.f; if (s) v *= s[k0 + kk]; scr[kk * 33 + (lane & 31)] = v; }
    LDS_WAIT(); asm volatile("" ::: "memory");
    const int c = lane & 7;
#pragma unroll
    for (int j = 0; j < 4; ++j) { const int nn = (lane >> 3) + 8 * j; const LAS float* sp = scr + (8 * c) * 33 + nn;
        u32x4 o; o.x = pk2(sp[0 * 33], sp[1 * 33]); o.y = pk2(sp[2 * 33], sp[3 * 33]); o.z = pk2(sp[4 * 33], sp[5 * 33]); o.w = pk2(sp[6 * 33], sp[7 * 33]);
        *(u32x4*)(WT + (size_t)(n0 + nn) * K + k0 + 8 * c) = o; }
    LDS_WAIT(); asm volatile("" ::: "memory");
}

__global__ void __launch_bounds__(NTHREADS, 2) mega(Args a) {
    extern __shared__ __attribute__((aligned(16))) unsigned char lds[];
    cg::grid_group grid = cg::this_grid();
    const int tid = threadIdx.x, lane = tid & 63, wave = __builtin_amdgcn_readfirstlane(tid >> 6);
    const int G = gridDim.x, bx = blockIdx.x, vcu = (G % 8 == 0) ? (bx % 8) * (G / 8) + bx / 8 : bx;
    const int gw = vcu * NWAVES + wave, NGW = G * NWAVES;
    unsigned char* ws = a.ws;
    const float* x = a.in[0];
    bf16_t* WA = (bf16_t*)(ws + WS_WA); bf16_t* WOA = (bf16_t*)(ws + WS_WOA); bf16_t* WC = (bf16_t*)(ws + WS_WC); bf16_t* WOC = (bf16_t*)(ws + WS_WOC);
    float* DT = (float*)(ws + WS_DT); float* SSQ = (float*)(ws + WS_SSQ); float* RSTD0 = (float*)(ws + WS_RSTD0); float* SSQ1 = (float*)(ws + WS_SSQ1);
    bf16_t* PROJ = (bf16_t*)(ws + WS_PROJ); float* X1 = (float*)(ws + WS_X1); bf16_t* XB1 = (bf16_t*)(ws + WS_XB1); bf16_t* PROJC = (bf16_t*)(ws + WS_PROJC); bf16_t* OGb = (bf16_t*)(ws + WS_OG);
    bf16_t* XB = (bf16_t*)a.out; bf16_t* Y = (bf16_t*)a.out;
    const int lo = a.ph_lo, hi = a.ph_hi;
#define IN(k) (lo <= (k) && (k) < hi)
#define SEAM(k) do { if (IN(k) && IN((k) + 1)) grid.sync(); } while (0)

    if (IN(0)) {
        LAS float* scr = (LAS float*)((LAS unsigned char*)lds + wave * 16384);
        constexpr int I_A = (DM / 64) * (NA_PAD / 32), I_OA = (2048 / 64) * (DM / 32), I_C = (DM / 64) * (ODD_IN / 32), I_OC = (DM / 64) * (DM / 32);
        for (int it = gw; it < I_A + I_OA + I_C + I_OC; it += NGW) {
            int r = it;
            if (r < I_A) { p0_transpose_item(a.in[2], a.in[1], DM, EVEN_IN, WA, scr, r, NA_PAD / 32, lane); continue; } r -= I_A;
            if (r < I_OA) { p0_transpose_item(a.in[14], nullptr, 2048, DM, WOA, scr, r, DM / 32, lane); continue; } r -= I_OA;
            if (r < I_C) { p0_transpose_item(a.in[16], a.in[15], DM, ODD_IN, WC, scr, r, ODD_IN / 32, lane); continue; } r -= I_C;
            p0_transpose_item(a.in[19], nullptr, DM, DM, WOC, scr, r, DM / 32, lane);
        }
        for (int m = gw; m < MROWS; m += NGW) {
            const f32x4* xr = (const f32x4*)(x + (size_t)m * DM) + lane; float s = 0.f;
            unsigned long long* o8 = (unsigned long long*)(XB + (size_t)m * DM) + lane;
#pragma unroll
            for (int j = 0; j < 4; ++j) { const f32x4 v = xr[64 * j]; s += (v.x * v.x + v.y * v.y) + (v.z * v.z + v.w * v.w); o8[64 * j] = (unsigned long long)pk2(v.x, v.y) | ((unsigned long long)pk2(v.z, v.w) << 32); }
            s = wave_sum(s);
            if (lane == 0) RSTD0[m] = 1.f / sqrtf(s * (1.f / DM) + EPS);
        }
    }
    SEAM(0);
    if (IN(1)) {
        pg8::Gemm g{XB, WA, MROWS, NA_PAD, DM}; pg8::StaticOrder S; S.init(MROWS, NA_PAD, G, bx);
        pg8::EpiProjA E{PROJ, DT, RSTD0, PROJ_P, PROJ_P / 256};
        pg8::gemm_phase<pg8::EpiProjA, pg8::StaticOrder, true, true>((LAS unsigned char*)lds, g, S, E);
    }
    SEAM(1);
    if (IN(2)) {
        if (a.skip & 1) { }
        else if (a.fast & 1) {
            float s1 = 0.f, s2 = 0.f; for (int i = 0; i < 64; ++i) { s1 += a.in[9][i] * a.in[10][i]; s2 += a.in[11][i] * a.in[12][i]; }
            const float lam = __expf(s1) - __expf(s2) + LAMBDA_INIT;
            bf16_t* Yo = a.alt ? (bf16_t*)a.alt : Y; const int yp = a.alt ? a.altpitch : 2048;
            for (int ug = vcu; ug < 256; ug += G) { const int bh = ug >> 1, sub = ug & 1;
                for (int i = 0; i < 8; ++i) { const int j = 2 * (i >> 1) + sub, qblk = (i & 1) ? 15 - j : j; fast_diffattn_unit(bh >> 3, bh & 7, qblk, (LAS unsigned char*)lds, PROJ, lam, a.in[13], Yo, yp); } }
        } else
        for (int u = bx; u < 2048; u += G) slow_diffattn_unit(u, tid, PROJ, a.in[9], a.in[10], a.in[11], a.in[12], a.in[13], Y);
        if (a.skip & 2) { }
        else if (a.fast & 2) { const bool dbg = a.alt2 != nullptr; bf16_t* Yo = dbg ? (bf16_t*)a.alt : Y;
            for (int u = vcu; u < 256; u += G) fast_ssd_unit(u >> 4, u & 15, (LAS unsigned char*)lds, PROJ, DT, a.in[3], a.in[4], a.in[5], a.in[6], a.in[7], Yo, dbg ? a.altpitch : 2048, dbg ? 0 : 1024, dbg ? (float*)a.alt2 : SSQ); }
        else
        for (int pr = bx; pr < 128; pr += G) slow_ssd_pair(pr, tid, (LAS float*)lds, PROJ, DT, a.in[3], a.in[4], a.in[5], a.in[6], a.in[7], Y, SSQ);
    }
    SEAM(2);
    if (IN(3)) {
        const float* w = a.in[8];
        for (int m = gw; m < MROWS; m += NGW) {
            const float* sq = SSQ + (size_t)m * 16;
#pragma unroll
            for (int g = 0; g < 2; ++g) {
                float s = 0.f;
#pragma unroll
                for (int i = 0; i < 8; ++i) s += sq[g * 8 + i];
                const float r = 1.f / sqrtf(s * (1.f / 512.f) + EPS);
                u32x4* yp = (u32x4*)(Y + (size_t)m * 2048 + 1024 + g * 512) + lane; const float* wp = w + g * 512 + lane * 8;
                u32x4 v = *yp;
#pragma unroll
                for (int i = 0; i < 4; ++i) v[i] = pk2(bf2f(v[i] & 0xffffu) * r * wp[2 * i], bf2f(v[i] >> 16) * r * wp[2 * i + 1]);
                *yp = v;
            }
        }
    }
    SEAM(3);
    if (IN(4)) {
        pg8::Gemm g{Y, WOA, MROWS, DM, 2048}; pg8::StaticOrder S; S.init(MROWS, DM, G, bx);
        pg8::EpiRes E{x, X1, XB1, SSQ1, DM};
        pg8::gemm_phase<pg8::EpiRes, pg8::StaticOrder, true, true>((LAS unsigned char*)lds, g, S, E);
    }
    SEAM(4);
    if (IN(5)) {
        pg8::Gemm g{XB1, WC, MROWS, ODD_IN, DM}; pg8::StaticOrder S; S.init(MROWS, ODD_IN, G, bx);
        pg8::EpiProjC E{PROJC, SSQ1, a.in[17], ODD_IN, 1.f / DM, EPS};
        pg8::gemm_phase<pg8::EpiProjC, pg8::StaticOrder, true, true>((LAS unsigned char*)lds, g, S, E);
    }
    SEAM(5);
    if (IN(6)) {
        if (a.fast & 4) { bf16_t* Oo = a.alt ? (bf16_t*)a.alt : OGb; const int op = a.alt ? a.altpitch : DM;
            for (int ug = vcu; ug < 256; ug += G) fast_swa_group(ug, (LAS unsigned char*)lds, PROJC, a.in[18], Oo, op); }
        else
        for (int u = bx; u < 1024; u += G) slow_swa_unit(u, tid, PROJC, a.in[18], OGb);
    }
    SEAM(6);
    if (IN(7)) {
        pg8::Gemm g{OGb, WOC, MROWS, DM, DM}; pg8::StaticOrder S; S.init(MROWS, DM, G, bx);
        pg8::EpiRes E{X1, X1, nullptr, nullptr, DM};
        pg8::gemm_phase<pg8::EpiRes, pg8::StaticOrder, true, true>((LAS unsigned char*)lds, g, S, E);
    }
    SEAM(7);
    if (IN(8)) {
        const f32x4* wr = (const f32x4*)a.in[20] + lane;
        for (int m = gw; m < MROWS; m += NGW) {
            const f32x4* xr = (const f32x4*)(X1 + (size_t)m * DM) + lane; f32x4 v[4]; float s = 0.f;
#pragma unroll
            for (int j = 0; j < 4; ++j) { v[j] = xr[64 * j]; s += (v[j].x * v[j].x + v[j].y * v[j].y) + (v[j].z * v[j].z + v[j].w * v[j].w); }
            s = wave_sum(s); const float r = 1.f / sqrtf(s * (1.f / DM) + EPS);
            f32x4* o = (f32x4*)(a.out + (size_t)m * DM) + lane;
#pragma unroll
            for (int j = 0; j < 4; ++j) o[64 * j] = v[j] * r * wr[64 * j];
        }
    }
#undef IN
#undef SEAM
}

#ifndef DEBUG_CMP
#define DEBUG_CMP 0
#endif
#ifndef FAST_MASK
#define FAST_MASK 7
#endif
#ifndef CMP_R0
#define CMP_R0 0
#define CMP_R1 2048
#define CMP_C0 0
#define CMP_C1 1024
#endif
constexpr size_t WS_ALT = 448 * MiB;
__global__ void __launch_bounds__(256) k_cmp_bf16(const bf16_t* A, int pa, const bf16_t* B, int pb, int ncol, int r0, int r1, int c0, int c1, float* met) {
    float sd = 0.f, sr = 0.f;
    for (size_t i = (size_t)blockIdx.x * 256 + threadIdx.x; i < (size_t)MROWS * ncol; i += (size_t)gridDim.x * 256) {
        const int row = (int)(i / ncol), col = (int)(i % ncol), sp = row % SEQ;
        if (sp < r0 || sp >= r1 || col < c0 || col >= c1) continue;
        const float x = bf2f(A[(size_t)row * pa + col]), y = bf2f(B[(size_t)row * pb + col]); const float d = x - y;
        sd += (d == d) ? d * d : 1e6f; sr += x * x;
    }
    sd = wave_sum(sd); sr = wave_sum(sr);
    if ((threadIdx.x & 63) == 0) { atomicAdd(met, sd); atomicAdd(met + 1, sr); }
}
__global__ void __launch_bounds__(256) k_inject(float* out, const float* met) {
    const float rel = fminf(sqrtf(met[0] / fmaxf(met[1], 1e-30f)), 3.f);
    f32x4* o = (f32x4*)out + (size_t)blockIdx.x * 256 + threadIdx.x; *o = *o * (1.f + rel);
}
static int g_grid = 0;
static void launch_mega(const Args& base, int lo, int hi, hipStream_t stream) {
    Args a = base; a.ph_lo = lo; a.ph_hi = hi; void* params[] = {&a};
    hipError_t e = hipLaunchCooperativeKernel((const void*)mega, dim3(g_grid), dim3(NTHREADS), params, LDS_BYTES, stream);
    if (e != hipSuccess) fprintf(stderr, "kernel_launch: cooperative launch [%d,%d) failed: %s (grid %d)\n", lo, hi, hipGetErrorString(e), g_grid);
}
extern "C" void kernel_launch(void* const* d_in, const int* in_sizes, int n_in, void* d_out, int out_size, void* d_ws, size_t ws_size, hipStream_t stream) {
    if (n_in != 21 || in_sizes[0] != MROWS * DM || out_size != MROWS * DM || ws_size < WS_END) { fprintf(stderr, "kernel_launch: unexpected shapes (n_in %d, ws %zu)\n", n_in, ws_size); return; }
    if (g_grid == 0) {
        int dev = 0, cus = 0, per_cu = 0;
        (void)hipGetDevice(&dev); (void)hipDeviceGetAttribute(&cus, hipDeviceAttributeMultiprocessorCount, dev);
        if (hipFuncSetAttribute((const void*)mega, hipFuncAttributeMaxDynamicSharedMemorySize, LDS_BYTES) != hipSuccess) { fprintf(stderr, "kernel_launch: hipFuncSetAttribute failed\n"); g_grid = -1; return; }
        if (hipOccupancyMaxActiveBlocksPerMultiprocessor(&per_cu, (const void*)mega, NTHREADS, LDS_BYTES) != hipSuccess || per_cu < 1) { fprintf(stderr, "kernel_launch: occupancy query says %d blocks per CU\n", per_cu); g_grid = -1; return; }
        g_grid = cus;
        fprintf(stderr, "kernel_launch: %d CUs, %d blocks/CU admitted, grid %d\n", cus, per_cu, g_grid);
    }
    if (g_grid < 0) return;
    unsigned char* ws = (unsigned char*)d_ws;
    Args a{}; for (int i = 0; i < 21; ++i) a.in[i] = (const float*)d_in[i];
    a.out = (float*)d_out; a.ws = ws; a.fast = FAST_MASK;
#if DEBUG_CMP == 0
    launch_mega(a, 0, NPHASE, stream);
#else
    float* met = (float*)(ws + WS_CTL);
    (void)hipMemsetAsync(met, 0, 256, stream);
    a.fast = 0; launch_mega(a, 0, 3, stream);
    Args f = a; f.fast = FAST_MASK;
#if DEBUG_CMP == 1
    f.alt = ws + WS_ALT; f.altpitch = 1024; launch_mega(f, 2, 3, stream);
    k_cmp_bf16<<<1024, 256, 0, stream>>>((const bf16_t*)d_out, 2048, (const bf16_t*)(ws + WS_ALT), 1024, 1024, CMP_R0, CMP_R1, CMP_C0, CMP_C1, met);
#endif
#if DEBUG_CMP == 2
    f.alt = ws + WS_ALT; f.altpitch = 1024; f.alt2 = ws + WS_RSTD0; f.skip = 1; launch_mega(f, 2, 3, stream);
    k_cmp_bf16<<<1024, 256, 0, stream>>>((const bf16_t*)d_out + 1024, 2048, (const bf16_t*)(ws + WS_ALT), 1024, 1024, CMP_R0, CMP_R1, CMP_C0, CMP_C1, met);
#endif
    launch_mega(a, 3, NPHASE, stream);
    k_inject<<<MROWS * DM / 4 / 256, 256, 0, stream>>>((float*)d_out, met);
#endif
}
```

```cpp
#include <hip/hip_runtime.h>
#include <cstdio>
#include <cstdint>
#include <cmath>

typedef unsigned short bf16_t;
typedef unsigned u32x4 __attribute__((ext_vector_type(4)));
typedef float f32x4 __attribute__((ext_vector_type(4)));

constexpr int BATCH = 16, SEQ = 2048, DM = 1024, MROWS = BATCH * SEQ;
constexpr int EVEN_IN = 6672, PROJ_P = 6656, NA_PAD = 6912;
constexpr int CQ = 0, CK = 1024, CV = 2048, CGA = 3072, CZ = 4096, CXS = 5120, CBM = 6144, CCM = 6400, CDT = 6656;
constexpr int ODD_IN = 2304;
constexpr int OQ = 0, OK_ = 1024, OV = 1152, OG_ = 1280;
constexpr float EPS = 1e-5f;
constexpr float LAMBDA_INIT = 0.2f;
constexpr float LOG2E = 1.4426950408889634f;
#ifndef REP_MASK
#define REP_MASK 0
#endif

constexpr size_t MiB = 1u << 20;
constexpr size_t WS_CTL = 0;
constexpr size_t WS_WA = 1 * MiB;
constexpr size_t WS_WOA = 15 * MiB;
constexpr size_t WS_WC = 19 * MiB;
constexpr size_t WS_WOC = 24 * MiB;
constexpr size_t WS_DT = 26 * MiB;
constexpr size_t WS_SSQ = 28 * MiB;
constexpr size_t WS_RSTD0 = 30 * MiB;
constexpr size_t WS_RSTD1 = 30 * MiB + 256 * 1024;
constexpr size_t WS_SSQ1 = WS_DT;
constexpr size_t WS_PROJ = 32 * MiB;
constexpr size_t WS_X1 = 32 * MiB;
constexpr size_t WS_XB1 = 160 * MiB;
constexpr size_t WS_PROJC = 224 * MiB;
constexpr size_t WS_OG = 368 * MiB;
constexpr size_t WS_END = 448 * MiB;

__device__ __forceinline__ unsigned f2bf(float f) { unsigned u = __builtin_bit_cast(unsigned, f); return (u + 0x7fffu + ((u >> 16) & 1u)) >> 16; }
__device__ __forceinline__ float bf2f(unsigned h) { return __builtin_bit_cast(float, h << 16); }
__device__ __forceinline__ unsigned pk2(float lo, float hi) { return f2bf(lo) | (f2bf(hi) << 16); }
__device__ __forceinline__ float silu_f(float v) { return v / (1.f + __expf(-v)); }
__device__ __forceinline__ float wave_sum(float v) {
#pragma unroll
    for (int o = 1; o < 64; o <<= 1) v += __shfl_xor(v, o);
    return v;
}

#define LAS __attribute__((address_space(3)))
__device__ __forceinline__ void slow_diffattn_unit(int unit, int tid, const bf16_t* proj, const float* lq1, const float* lk1, const float* lq2, const float* lk2, const float* subln, bf16_t* Y) {
    const int qb = unit & 15, h = (unit >> 4) & 7, b = unit >> 7, qi = tid >> 2, eq = tid & 3;
    const int qpos = qb * 128 + qi; const size_t row = (size_t)b * SEQ + qpos;
    float s1 = 0.f, s2 = 0.f; for (int i = 0; i < 64; ++i) { s1 += lq1[i] * lk1[i]; s2 += lq2[i] * lk2[i]; }
    const float lam = __expf(s1) - __expf(s2) + LAMBDA_INIT;
    const float slope = exp2f(-(float)(h + 1));
    float q0[16], q1[16];
    { const bf16_t* qp = proj + row * PROJ_P + CQ + h * 128 + eq * 16;
#pragma unroll
      for (int i = 0; i < 16; ++i) { q0[i] = bf2f(qp[i]); q1[i] = bf2f(qp[64 + i]); } }
    float o0[32], o1[32];
#pragma unroll
    for (int i = 0; i < 32; ++i) { o0[i] = 0.f; o1[i] = 0.f; }
    float m0 = -INFINITY, m1 = -INFINITY, l0 = 0.f, l1 = 0.f;
    const int jmax = qb * 128 + 127;
    for (int j = 0; j <= jmax; ++j) {
        const bf16_t* kp = proj + ((size_t)b * SEQ + j) * PROJ_P + CK + h * 128 + eq * 16;
        float d0 = 0.f, d1 = 0.f;
#pragma unroll
        for (int i = 0; i < 16; ++i) { d0 += q0[i] * bf2f(kp[i]); d1 += q1[i] * bf2f(kp[64 + i]); }
        d0 += __shfl_xor(d0, 1); d0 += __shfl_xor(d0, 2); d1 += __shfl_xor(d1, 1); d1 += __shfl_xor(d1, 2);
        if (j <= qpos) {
            const float bias = slope * (float)(qpos - j);
            const float a0 = d0 * (1.f / LOG2E) - bias, a1 = d1 * (1.f / LOG2E) - bias;
            const float n0 = fmaxf(m0, a0), n1 = fmaxf(m1, a1);
            const float c0 = __expf(m0 - n0), c1 = __expf(m1 - n1), p0 = __expf(a0 - n0), p1 = __expf(a1 - n1);
            m0 = n0; m1 = n1; l0 = l0 * c0 + p0; l1 = l1 * c1 + p1;
            const bf16_t* vp = proj + ((size_t)b * SEQ + j) * PROJ_P + CV + h * 128 + eq * 32;
#pragma unroll
            for (int i = 0; i < 32; ++i) { const float v = bf2f(vp[i]); o0[i] = o0[i] * c0 + p0 * v; o1[i] = o1[i] * c1 + p1 * v; }
        }
    }
    const float i0 = 1.f / l0, i1 = lam / l1; float ss = 0.f;
#pragma unroll
    for (int i = 0; i < 32; ++i) { o0[i] = o0[i] * i0 - o1[i] * i1; ss += o0[i] * o0[i]; }
    ss += __shfl_xor(ss, 1); ss += __shfl_xor(ss, 2);
    const float r = (1.f - LAMBDA_INIT) / sqrtf(ss * (1.f / 128.f) + EPS);
    const bf16_t* gp = proj + row * PROJ_P + CGA + h * 128 + eq * 32; bf16_t* yp = Y + row * 2048 + h * 128 + eq * 32;
#pragma unroll
    for (int i = 0; i < 32; ++i) yp[i] = (bf16_t)f2bf(o0[i] * r * subln[eq * 32 + i] * silu_f(bf2f(gp[i])));
}

__device__ __forceinline__ void slow_ssd_pair(int pair, int tid, LAS float* sm, const bf16_t* proj, const float* dtraw, const float* conv_w, const float* conv_b, const float* dt_bias, const float* a_log,
                                              const float* d_skip, bf16_t* Y, float* ssq) {
    const int half = tid >> 8, t = tid & 255, unit = pair * 2 + half, hd = unit & 15, b = unit >> 4, g = hd >> 3, p = t >> 2, nq = t & 3;
    LAS float* sB = sm + half * 272; LAS float* sC = sB + 128; LAS float* sRed = sB + 256;
    const int cbc = (t < 128) ? (1024 + g * 128 + t) : (1024 + 256 + g * 128 + (t - 128));
    const int cx = hd * 64 + p;
    float wbc[4], wx[4];
#pragma unroll
    for (int j = 0; j < 4; ++j) { wbc[j] = conv_w[j * 1536 + cbc]; wx[j] = conv_w[j * 1536 + cx]; }
    const float bbc = conv_b[cbc], bx = conv_b[cx];
    const float A = -__expf(a_log[hd]), dtb = dt_bias[hd], Dk = d_skip[hd];
    float hbc[3] = {0.f, 0.f, 0.f}, hx[3] = {0.f, 0.f, 0.f};
    float st[32];
#pragma unroll
    for (int i = 0; i < 32; ++i) st[i] = 0.f;
    for (int ts = 0; ts < SEQ; ++ts) {
        const size_t row = (size_t)b * SEQ + ts; const bf16_t* pr = proj + row * PROJ_P;
        const float rbc = bf2f(pr[CXS + cbc]);
        const float vbc = silu_f(wbc[0] * hbc[0] + wbc[1] * hbc[1] + wbc[2] * hbc[2] + wbc[3] * rbc + bbc);
        hbc[0] = hbc[1]; hbc[1] = hbc[2]; hbc[2] = rbc;
        if (t < 128) sB[t] = bf2f(f2bf(vbc)); else sC[t - 128] = bf2f(f2bf(vbc));
        const float rx = bf2f(pr[CXS + cx]);
        const float vx = bf2f(f2bf(silu_f(wx[0] * hx[0] + wx[1] * hx[1] + wx[2] * hx[2] + wx[3] * rx + bx)));
        hx[0] = hx[1]; hx[1] = hx[2]; hx[2] = rx;
        const float dr = dtraw[row * 16 + hd] + dtb; const float dt = (dr > 20.f) ? dr : log1pf(__expf(dr));
        const float dec = __expf(dt * A), dtx = dt * vx;
        __syncthreads();
        float y = 0.f;
#pragma unroll
        for (int i = 0; i < 32; ++i) { st[i] = st[i] * dec + dtx * sB[nq * 32 + i]; y += sC[nq * 32 + i] * st[i]; }
        y += __shfl_xor(y, 1); y += __shfl_xor(y, 2);
        const float z = bf2f(pr[CZ + hd * 64 + p]);
        const float yz = (y + Dk * vx) * silu_f(z);
        float q = (nq == 0) ? yz * yz : 0.f; q = wave_sum(q);
        if ((t & 63) == 0) sRed[t >> 6] = q;
        if (nq == 0) Y[row * 2048 + 1024 + hd * 64 + p] = (bf16_t)f2bf(yz);
        __syncthreads();
        if (t == 0) ssq[row * 16 + hd] = sRed[0] + sRed[1] + sRed[2] + sRed[3];
    }
}
__device__ __forceinline__ void slow_swa_unit(int unit, int tid, const bf16_t* projc, const float* sinks, bf16_t* OGb) {
    const int qpos = (unit & 3) * 512 + tid, h = (unit >> 2) & 15, b = unit >> 6, kvh = h >> 3;
    const size_t row = (size_t)b * SEQ + qpos;
    const float slope = exp2f(-0.5f * (float)(h + 1));
    float q[64], o[64];
    { const bf16_t* qp = projc + row * ODD_IN + OQ + h * 64;
#pragma unroll
      for (int i = 0; i < 64; ++i) { q[i] = bf2f(qp[i]); o[i] = 0.f; } }
    float m = sinks[h], l = 1.f;
    const int j0 = (qpos - 127 > 0) ? qpos - 127 : 0;
    for (int j = j0; j <= qpos; ++j) {
        const bf16_t* kp = projc + ((size_t)b * SEQ + j) * ODD_IN + OK_ + kvh * 64; float d = 0.f;
#pragma unroll
        for (int i = 0; i < 64; ++i) d += q[i] * bf2f(kp[i]);
        const float a = d * 0.125f - slope * (float)(qpos - j);
        const float n = fmaxf(m, a), c = __expf(m - n), p = __expf(a - n);
        m = n; l = l * c + p;
        const bf16_t* vp = projc + ((size_t)b * SEQ + j) * ODD_IN + OV + kvh * 64;
#pragma unroll
        for (int i = 0; i < 64; ++i) o[i] = o[i] * c + p * bf2f(vp[i]);
    }
    const float il = 1.f / l; const bf16_t* gp = projc + row * ODD_IN + OG_ + h * 64; bf16_t* op = OGb + row * DM + h * 64;
#pragma unroll
    for (int i = 0; i < 64; ++i) op[i] = (bf16_t)f2bf(o[i] * il * silu_f(bf2f(gp[i])));
}

namespace pg8 {
#define PG8_LAS __attribute__((address_space(3)))
typedef unsigned short bf16_t;
typedef short bf16x8 __attribute__((ext_vector_type(8)));
typedef float f32x4 __attribute__((ext_vector_type(4)));
typedef unsigned u32x4 __attribute__((ext_vector_type(4)));
constexpr int BM = 256, BK = 64, HALF = 128, HTB = HALF * BK * 2  , STAGE_BYTES = 8 * HTB, NXCD = 8, WGM = 8;

__host__ __device__ __forceinline__ int lds_byte(int r, int c) { const int st = (r >> 4) * 2 + (c >> 5), rr = r & 15, cc = c & 31, ob = rr * 64 + cc * 2; return st * 1024 + (ob ^ (((ob >> 9) & 1) << 5)); }
__host__ __device__ __forceinline__ void stage_rc(int b, int& R, int& C) { const int st = b / 1024, sb = b % 1024, swz = sb ^ (((sb >> 9) & 1) << 5); R = (st >> 1) * 16 + swz / 64; C = (st & 1) * 32 + (swz % 64) / 2; }
__host__ __device__ __forceinline__ int perm32(int rho) { const int n = rho >> 4, i = rho & 15; return 8 * (i >> 2) + 4 * n + (i & 3); }

struct Unit { int pm, pn; };
struct Gemm { const bf16_t* A; const bf16_t* Bt; int M, N, K; };

struct StaticOrder {
    int nM, nN, nwg, G, c;
    __host__ __device__ void init(int M, int N, int G_, int c_) { nM = M / BM; nN = N / BM; nwg = nM * nN; G = G_; c = c_; }
    __host__ __device__ bool next(int i, Unit& u) const {
        const long L = (long)i * G + c; if (L >= nwg) return false;
        int wgid = (int)L; { const int q = nwg / NXCD, r = nwg % NXCD, xcd = wgid % NXCD, off = wgid / NXCD; wgid = (xcd < r ? xcd * (q + 1) : r * (q + 1) + (xcd - r) * q) + off; }
        const int nig = WGM * nN, gid = wgid / nig, fm = gid * WGM, gsz = (nM - fm) < WGM ? (nM - fm) : WGM;
        u.pm = fm + ((wgid % nig) % gsz); u.pn = (wgid % nig) / gsz; return true;
    }
    __device__ __forceinline__ void a_ready(const Unit&) const {}
    __device__ __forceinline__ void done(const Unit&) const {}
};


__device__ __forceinline__ unsigned cvt_pk_bf16(float lo, float hi) { unsigned r; asm volatile("v_cvt_pk_bf16_f32 %0, %1, %2" : "=v"(r) : "v"(lo), "v"(hi)); return r; }
struct EpiProjA {
    static constexpr bool PERM = true, AFTER_DRAIN = false;
    bf16_t* proj; float* dt; const float* rstd; int pitch, ntile_bf16, ntile_q; float qscale;
    __device__ __forceinline__ void operator()(const f32x4 (&acc)[2][2][4][2], const Unit& u, int wr, int wc, int fr, int fq) const {
        const int row0 = u.pm * BM + wr * 64 + fr;
        if (u.pn < ntile_bf16) {
            const int col0 = u.pn * BM + wc * 32 + 8 * fq;
#pragma unroll
            for (int ai = 0; ai < 2; ++ai)
#pragma unroll
                for (int m = 0; m < 4; ++m) { const int row = row0 + ai * HALF + m * 16; const float rs = rstd[row] * ((u.pn < ntile_q) ? qscale : 1.f); bf16_t* rowp = proj + (size_t)row * pitch + col0;
#pragma unroll
                    for (int bj = 0; bj < 2; ++bj) { const f32x4 v0 = acc[ai][bj][m][0] * rs, v1 = acc[ai][bj][m][1] * rs;
                        u32x4 w; w.x = cvt_pk_bf16(v0[0], v0[1]); w.y = cvt_pk_bf16(v0[2], v0[3]); w.z = cvt_pk_bf16(v1[0], v1[1]); w.w = cvt_pk_bf16(v1[2], v1[3]);
                        *(u32x4*)(rowp + bj * HALF) = w; } }
        } else if (wc == 0 && fq < 2) {
#pragma unroll
            for (int ai = 0; ai < 2; ++ai)
#pragma unroll
                for (int m = 0; m < 4; ++m) { const int row = row0 + ai * HALF + m * 16; const float rs = rstd[row]; float* dp = dt + (size_t)row * 16 + 8 * fq;
                    *(f32x4*)dp = acc[ai][0][m][0] * rs; *(f32x4*)(dp + 4) = acc[ai][0][m][1] * rs; }
        }
    }
};
struct EpiRes {
    static constexpr bool PERM = true, AFTER_DRAIN = false;
    const float* xin; float* xout; bf16_t* xb; float* ssq; int ldc;
    __device__ __forceinline__ void operator()(const f32x4 (&acc)[2][2][4][2], const Unit& u, int wr, int wc, int fr, int fq) const {
        const int row0 = u.pm * BM + wr * 64 + fr, col0 = u.pn * BM + wc * 32 + 8 * fq;
#pragma unroll
        for (int ai = 0; ai < 2; ++ai)
#pragma unroll
            for (int m = 0; m < 4; ++m) { const int row = row0 + ai * HALF + m * 16; const size_t off = (size_t)row * ldc + col0; float s = 0.f;
#pragma unroll
                for (int bj = 0; bj < 2; ++bj) { const f32x4 a = *(const f32x4*)(xin + off + bj * HALF), b = *(const f32x4*)(xin + off + bj * HALF + 4);
                    const f32x4 o0 = a + acc[ai][bj][m][0], o1 = b + acc[ai][bj][m][1];
                    *(f32x4*)(xout + off + bj * HALF) = o0; *(f32x4*)(xout + off + bj * HALF + 4) = o1;
                    s += (o0[0] * o0[0] + o0[1] * o0[1]) + (o0[2] * o0[2] + o0[3] * o0[3]) + (o1[0] * o1[0] + o1[1] * o1[1]) + (o1[2] * o1[2] + o1[3] * o1[3]);
                    if (xb) { u32x4 w; w.x = cvt_pk_bf16(o0[0], o0[1]); w.y = cvt_pk_bf16(o0[2], o0[3]); w.z = cvt_pk_bf16(o1[0], o1[1]); w.w = cvt_pk_bf16(o1[2], o1[3]); *(u32x4*)(xb + off + bj * HALF) = w; } }
                if (ssq) { s += __shfl_xor(s, 16); s += __shfl_xor(s, 32); if (fq == 0) ssq[(size_t)row * 16 + u.pn * 4 + wc] = s; }
                if (m & 1) asm volatile("" ::: "memory"); }
    }
};
struct EpiProjC {
    static constexpr bool PERM = true, AFTER_DRAIN = false;
    bf16_t* proj; const float* ssq; const float* bias; int pitch; float inv_n, eps;
    __device__ __forceinline__ void operator()(const f32x4 (&acc)[2][2][4][2], const Unit& u, int wr, int wc, int fr, int fq) const {
        const int row0 = u.pm * BM + wr * 64 + fr, col0 = u.pn * BM + wc * 32 + 8 * fq;
        f32x4 bv[2][2];
#pragma unroll
        for (int bj = 0; bj < 2; ++bj)
#pragma unroll
            for (int n = 0; n < 2; ++n) bv[bj][n] = *(const f32x4*)(bias + col0 + bj * HALF + 4 * n);
#pragma unroll
        for (int ai = 0; ai < 2; ++ai)
#pragma unroll
            for (int m = 0; m < 4; ++m) { const int row = row0 + ai * HALF + m * 16; const f32x4* sp = (const f32x4*)(ssq + (size_t)row * 16);
                const f32x4 p0 = sp[0], p1 = sp[1], p2 = sp[2], p3 = sp[3];
                const float ss = ((p0[0] + p0[1]) + (p0[2] + p0[3])) + ((p1[0] + p1[1]) + (p1[2] + p1[3])) + ((p2[0] + p2[1]) + (p2[2] + p2[3])) + ((p3[0] + p3[1]) + (p3[2] + p3[3]));
                const float rs = 1.0f / sqrtf(ss * inv_n + eps); bf16_t* rowp = proj + (size_t)row * pitch + col0;
#pragma unroll
                for (int bj = 0; bj < 2; ++bj) { const f32x4 v0 = acc[ai][bj][m][0] * rs + bv[bj][0], v1 = acc[ai][bj][m][1] * rs + bv[bj][1];
                    u32x4 w; w.x = cvt_pk_bf16(v0[0], v0[1]); w.y = cvt_pk_bf16(v0[2], v0[3]); w.z = cvt_pk_bf16(v1[0], v1[1]); w.w = cvt_pk_bf16(v1[2], v1[3]);
                    *(u32x4*)(rowp + bj * HALF) = w; }
                if (m & 1) asm volatile("" ::: "memory"); }
    }
};

template <class Epi, class Sched, bool ALIGN_EPI = false, bool SP2 = false>
__device__ __forceinline__ void gemm_phase(PG8_LAS unsigned char* lds, const Gemm g, const Sched& S, const Epi& E) {
    const int tid = threadIdx.x, wid = __builtin_amdgcn_readfirstlane(tid >> 6), lane = tid & 63, wr = wid >> 2, wc = wid & 3, fr = lane & 15, fq = lane >> 4;
    const int K = g.K, nt = K / BK;
    unsigned voffA[2], voffB[2];
#pragma unroll
    for (int i = 0; i < 2; ++i) { int R, C; stage_rc(tid * 16 + i * 8192, R, C); const int Rb = Epi::PERM ? ((R & ~31) + perm32(R & 31)) : R;
        voffA[i] = (unsigned)(R * K + C) * 2u; voffB[i] = (unsigned)(Rb * K + C) * 2u; }
    const size_t kstep = (size_t)(BK * 2);
    const size_t hstep = (size_t)HALF * K * 2;
    const size_t tstep = 2 * hstep;
    const unsigned ldsw = (unsigned)wid * 1024u;
    const int aoff = lds_byte(wr * 64 + fr, fq * 8), boff = lds_byte(wc * 32 + fr, fq * 8);
#define PG8_SA(b, h) (((b) * 2 + (h)) * HTB)
#define PG8_SB(b, h) ((4 + (b) * 2 + (h)) * HTB)
#define PG8_STAGE(bufoff, gbase, voff) do { _Pragma("unroll") for (int _i = 0; _i < 2; ++_i) \
        __builtin_amdgcn_global_load_lds((const unsigned*)((const char*)(gbase) + (voff)[_i]), (PG8_LAS unsigned*)(lds + (bufoff) + ldsw + _i * 8192), 16, 0, 0); } while (0)
#define PG8_LDA(dst, b, h) do { _Pragma("unroll") for (int m = 0; m < 4; ++m) _Pragma("unroll") for (int k = 0; k < 2; ++k) dst[m][k] = *(const PG8_LAS bf16x8*)(lds + PG8_SA(b, h) + aoff + m * 2048 + k * 1024); } while (0)
#define PG8_LDB(dst, b, h) do { _Pragma("unroll") for (int n = 0; n < 2; ++n) _Pragma("unroll") for (int k = 0; k < 2; ++k) dst[n][k] = *(const PG8_LAS bf16x8*)(lds + PG8_SB(b, h) + boff + n * 2048 + k * 1024); } while (0)
#define PG8_MMA(ai, bj, At, Bt) do { __builtin_amdgcn_s_setprio(1); _Pragma("unroll") for (int m = 0; m < 4; ++m) _Pragma("unroll") for (int n = 0; n < 2; ++n) _Pragma("unroll") for (int k = 0; k < 2; ++k) \
        acc[ai][bj][m][n] = __builtin_amdgcn_mfma_f32_16x16x32_bf16(Bt[n][k], At[m][k], acc[ai][bj][m][n], 0, 0, 0); __builtin_amdgcn_s_setprio(0); } while (0)
#define PG8_WAIT_V(n) asm volatile("s_waitcnt vmcnt(" #n ")" ::: "memory")
#define PG8_WAIT_L(n) asm volatile("s_waitcnt lgkmcnt(" #n ")" ::: "memory")
#define PG8_BAR __builtin_amdgcn_s_barrier()
#define PG8_SCHED __builtin_amdgcn_sched_barrier(0)
    Unit cur, nxt; int ui = 0;
    if (!S.next(0, cur)) return;
    f32x4 acc[2][2][4][2];
#pragma unroll
    for (int a = 0; a < 2; ++a)
#pragma unroll
        for (int b = 0; b < 2; ++b)
#pragma unroll
            for (int m = 0; m < 4; ++m)
#pragma unroll
                for (int n = 0; n < 2; ++n) acc[a][b][m][n] = (f32x4){0.f, 0.f, 0.f, 0.f};
    bf16x8 At[4][2], B0[2][2], B1[2][2];
    const char* cA = (const char*)g.A + (size_t)cur.pm * tstep; const char* cB = (const char*)g.Bt + (size_t)cur.pn * tstep;
    S.a_ready(cur);
    if constexpr (SP2) {
        PG8_STAGE(PG8_SB(0, 0), cB, voffB); PG8_STAGE(PG8_SB(0, 1), cB + hstep, voffB); PG8_STAGE(PG8_SA(0, 0), cA, voffA); PG8_STAGE(PG8_SA(0, 1), cA + hstep, voffA);
        if (wr == 1) PG8_BAR;
        PG8_WAIT_V(2); PG8_BAR;
        PG8_STAGE(PG8_SB(1, 0), cB + kstep, voffB); PG8_STAGE(PG8_SA(1, 0), cA + kstep, voffA); PG8_STAGE(PG8_SB(1, 1), cB + hstep + kstep, voffB);
        PG8_WAIT_V(6); PG8_BAR;
    } else {
        PG8_STAGE(PG8_SB(0, 0), cB, voffB); PG8_STAGE(PG8_SA(0, 0), cA, voffA); PG8_STAGE(PG8_SB(0, 1), cB + hstep, voffB); PG8_STAGE(PG8_SA(0, 1), cA + hstep, voffA);
        if (wr == 1) PG8_BAR;
        PG8_WAIT_V(4); PG8_BAR;
        PG8_STAGE(PG8_SB(1, 0), cB + kstep, voffB); PG8_STAGE(PG8_SA(1, 0), cA + kstep, voffA); PG8_STAGE(PG8_SB(1, 1), cB + hstep + kstep, voffB);
        PG8_WAIT_V(6); PG8_BAR;
    }
    for (;;) {
        const bool has_next = S.next(ui + 1, nxt);
        const char* nA = has_next ? (const char*)g.A + (size_t)nxt.pm * tstep : cA; const char* nB = has_next ? (const char*)g.Bt + (size_t)nxt.pn * tstep : cB;
        for (int t = 0; t < nt; t += 2) {
            const bool last = (t == nt - 2);
            const char* a1 = cA + (size_t)(t + 1) * kstep;
            const char* a2 = last ? nA : cA + (size_t)(t + 2) * kstep; const char* b2 = last ? nB : cB + (size_t)(t + 2) * kstep;
            const char* a3 = a2 + kstep; const char* b3 = b2 + kstep;
            if (last && has_next) S.a_ready(nxt);
            if constexpr (SP2) {
            PG8_LDB(B0, 0, 0); PG8_LDB(B1, 0, 1); PG8_SCHED; PG8_LDA(At, 0, 0); PG8_STAGE(PG8_SA(1, 1), a1 + hstep, voffA);
            PG8_WAIT_V(8); PG8_WAIT_L(0); PG8_BAR; PG8_MMA(0, 0, At, B0); PG8_MMA(0, 1, At, B1); PG8_BAR; PG8_SCHED;
            PG8_LDA(At, 0, 1); PG8_STAGE(PG8_SB(0, 0), b2, voffB); PG8_STAGE(PG8_SB(0, 1), b2 + hstep, voffB); PG8_STAGE(PG8_SA(0, 0), a2, voffA);
            PG8_WAIT_V(8); PG8_WAIT_L(0); PG8_BAR; PG8_MMA(1, 0, At, B0); PG8_MMA(1, 1, At, B1); PG8_BAR; PG8_SCHED;
            PG8_LDB(B0, 1, 0); PG8_LDB(B1, 1, 1); PG8_SCHED; PG8_LDA(At, 1, 0); PG8_STAGE(PG8_SA(0, 1), a2 + hstep, voffA);
            PG8_WAIT_V(8); PG8_WAIT_L(0); PG8_BAR; PG8_MMA(0, 0, At, B0); PG8_MMA(0, 1, At, B1); PG8_BAR; PG8_SCHED;
            PG8_LDA(At, 1, 1); PG8_STAGE(PG8_SB(1, 0), b3, voffB); PG8_STAGE(PG8_SB(1, 1), b3 + hstep, voffB); PG8_STAGE(PG8_SA(1, 0), a3, voffA);
            PG8_WAIT_V(8); PG8_WAIT_L(0); PG8_BAR; PG8_MMA(1, 0, At, B0); PG8_MMA(1, 1, At, B1); PG8_BAR; PG8_SCHED;
            } else {
            PG8_LDB(B0, 0, 0); PG8_SCHED; PG8_LDA(At, 0, 0); PG8_STAGE(PG8_SA(1, 1), a1 + hstep, voffA);
            PG8_WAIT_L(8); PG8_BAR; PG8_WAIT_L(0); PG8_MMA(0, 0, At, B0); PG8_BAR; PG8_SCHED;
            PG8_LDB(B1, 0, 1); PG8_STAGE(PG8_SB(0, 0), b2, voffB);
            PG8_BAR; PG8_WAIT_L(0); PG8_MMA(0, 1, At, B1); PG8_BAR;
            PG8_LDA(At, 0, 1); PG8_STAGE(PG8_SA(0, 0), a2, voffA);
            PG8_BAR; PG8_WAIT_L(0); PG8_MMA(1, 0, At, B0); PG8_BAR; PG8_SCHED;
            PG8_STAGE(PG8_SB(0, 1), b2 + hstep, voffB);
            PG8_WAIT_V(6); PG8_BAR; PG8_MMA(1, 1, At, B1); PG8_BAR;
            PG8_LDB(B0, 1, 0); PG8_SCHED; PG8_LDA(At, 1, 0); PG8_STAGE(PG8_SA(0, 1), a2 + hstep, voffA);
            PG8_WAIT_L(8); PG8_BAR; PG8_WAIT_L(0); PG8_MMA(0, 0, At, B0); PG8_BAR; PG8_SCHED;
            PG8_LDB(B1, 1, 1); PG8_STAGE(PG8_SB(1, 0), b3, voffB);
            PG8_BAR; PG8_WAIT_L(0); PG8_MMA(0, 1, At, B1); PG8_BAR;
            PG8_LDA(At, 1, 1); PG8_STAGE(PG8_SA(1, 0), a3, voffA);
            PG8_BAR; PG8_WAIT_L(0); PG8_MMA(1, 0, At, B0); PG8_BAR; PG8_SCHED;
            PG8_STAGE(PG8_SB(1, 1), b3 + hstep, voffB);
            PG8_WAIT_V(6); PG8_BAR; PG8_MMA(1, 1, At, B1); PG8_BAR;
            }
        }
        if constexpr (ALIGN_EPI) { if (wr == 0) PG8_BAR; }
        if constexpr (!Epi::AFTER_DRAIN) { E(acc, cur, wr, wc, fr, fq); S.done(cur); }
        if (!has_next) break;
#pragma unroll
        for (int a = 0; a < 2; ++a)
#pragma unroll
            for (int b = 0; b < 2; ++b)
#pragma unroll
                for (int m = 0; m < 4; ++m)
#pragma unroll
                    for (int n = 0; n < 2; ++n) acc[a][b][m][n] = (f32x4){0.f, 0.f, 0.f, 0.f};
        cur = nxt; cA = nA; cB = nB; ++ui;
        if constexpr (ALIGN_EPI) { if (wr == 1) PG8_BAR; }
    }
    PG8_WAIT_V(0);
    if constexpr (!ALIGN_EPI) { if (wr == 0) PG8_BAR; }
    PG8_BAR;
    if constexpr (Epi::AFTER_DRAIN) { E.fused(acc, cur, wr, wc, fr, fq, lds, wid, lane); S.done(cur); }
#undef PG8_SA
#undef PG8_SB
#undef PG8_STAGE
#undef PG8_LDA
#undef PG8_LDB
#undef PG8_MMA
#undef PG8_WAIT_V
#undef PG8_WAIT_L
#undef PG8_BAR
#undef PG8_SCHED
}
}

typedef short bf16x8 __attribute__((ext_vector_type(8)));
typedef short s16x4 __attribute__((ext_vector_type(4)));
typedef short v4i16_t __attribute__((ext_vector_type(4)));
typedef float f32x16 __attribute__((ext_vector_type(16)));
typedef LAS const char* lds_cptr;
__device__ __forceinline__ int crow(int r, int hi) { return (r & 3) + 8 * (r >> 2) + 4 * hi; }
__device__ __forceinline__ s16x4 vtr(lds_cptr p) { return __builtin_bit_cast(s16x4, __builtin_amdgcn_ds_read_tr16_b64_v4i16((LAS v4i16_t*)p)); }
__device__ __forceinline__ unsigned cvtpk(float lo, float hi) { unsigned r; asm volatile("v_cvt_pk_bf16_f32 %0, %1, %2" : "=v"(r) : "v"(lo), "v"(hi)); return r; }
__device__ __forceinline__ float swap32_max(float v) { auto rr = __builtin_amdgcn_permlane32_swap(__float_as_uint(v), __float_as_uint(v), false, false); return fmaxf(__uint_as_float(rr[0]), __uint_as_float(rr[1])); }
__device__ __forceinline__ float swap32_sum(float v) { auto rr = __builtin_amdgcn_permlane32_swap(__float_as_uint(v), __float_as_uint(v), false, false); return __uint_as_float(rr[0]) + __uint_as_float(rr[1]); }
__device__ __forceinline__ float silu_fast(float v) { return v * __builtin_amdgcn_rcpf(1.f + __builtin_amdgcn_exp2f(-LOG2E * v)); }
#define MFMA32(a, b, c) __builtin_amdgcn_mfma_f32_32x32x16_bf16((a), (b), (c), 0, 0, 0)

constexpr int DA_KOFF = 0, DA_VOFF = 16384, DA_BUF = 32768, DA_WS = 65536, DA_DIFF = 69632, DA_DPITCH = 132;
constexpr float QPRE = 0.125f * LOG2E;
__device__ __forceinline__ void fast_diffattn_unit(int b, int h, int qblk, LAS unsigned char* lds, const bf16_t* proj, float lam, const float* subln, bf16_t* Y, int ypitch) {
    const int tid = threadIdx.x, lane = tid & 63, wave = __builtin_amdgcn_readfirstlane(tid >> 6), r32 = lane & 31, hh = lane >> 5, mp = wave >> 2, qs = wave & 3;
    const int q0 = qblk * 128 + qs * 32;
    const size_t rowbase = (size_t)b * SEQ;
    bf16x8 qf[4];
#pragma unroll
    for (int ds = 0; ds < 4; ++ds) qf[ds] = *(const bf16x8*)(proj + (rowbase + q0 + r32) * PROJ_P + CQ + h * 128 + mp * 64 + ds * 16 + hh * 8);
    const float slope2 = exp2f(-(float)(h + 1)) * LOG2E;
    f32x16 o[4];
#pragma unroll
    for (int d = 0; d < 4; ++d)
#pragma unroll
        for (int r = 0; r < 16; ++r) o[d][r] = 0.f;
    float m = 0.f, l = 0.f;
    LAS float* wsf = (LAS float*)(lds + DA_WS) + wave * 64;
    const int T = 2 * (qblk + 1);
    const int srow = 8 * wave + (lane >> 3), c8 = lane & 7;
    const bf16_t* ksrc = proj + (rowbase + srow) * PROJ_P + CK + h * 128 + c8 * 8;
    const bf16_t* vsrc = proj + (rowbase + srow) * PROJ_P + CV + h * 128 + c8 * 8;
    const int kdst = DA_KOFF + srow * 256 + ((c8 ^ (srow & 15)) * 16);
    const int vdst = DA_VOFF + ((c8 >> 2) * 4 + (srow >> 4)) * 1024 + (srow & 15) * 64 + (c8 & 3) * 16;
    u32x4 kr[2], vr[2];
#define DA_LOAD(t) do { const size_t to_ = (size_t)(t) * 64 * PROJ_P; kr[0] = *(const u32x4*)(ksrc + to_); kr[1] = *(const u32x4*)(ksrc + to_ + 64); vr[0] = *(const u32x4*)(vsrc + to_); vr[1] = *(const u32x4*)(vsrc + to_ + 64); } while (0)
#define DA_WRITE(bo) do { *(LAS u32x4*)(lds + (bo) + kdst) = kr[0]; *(LAS u32x4*)(lds + (bo) + (kdst ^ 128)) = kr[1]; *(LAS u32x4*)(lds + (bo) + vdst) = vr[0]; *(LAS u32x4*)(lds + (bo) + vdst + 8192) = vr[1]; } while (0)
    DA_LOAD(T - 1); DA_WRITE(0);
    __syncthreads();
    const int kf0 = DA_KOFF + r32 * 256 + (((8 * mp + hh) ^ (r32 & 15)) * 16);
    const int vfo = DA_VOFF + ((lane >> 4) & 1) * 32 + (lane & 3) * 8 + (4 * hh + ((lane & 15) >> 2)) * 64;
    for (int it = 0; it < T; ++it) {
        const int t = T - 1 - it, bo = (it & 1) * DA_BUF;
        if (it + 1 < T) DA_LOAD(t - 1);
        if (64 * t <= q0 + 31) {
            const float tbm = slope2 * (float)(64 * t + 4 * hh - q0) - m;
            f32x16 s0, s1;
#pragma unroll
            for (int r = 0; r < 16; ++r) { s0[r] = slope2 * (float)((r & 3) + 8 * (r >> 2)) + tbm; s1[r] = slope2 * (float)((r & 3) + 8 * (r >> 2) + 32) + tbm; }
#pragma unroll
            for (int ds = 0; ds < 4; ++ds) {
                lds_cptr ka = (lds_cptr)(lds + bo + (kf0 ^ (32 * ds)));
                const bf16x8 a0 = *(const LAS bf16x8*)(ka), a1 = *(const LAS bf16x8*)(ka + 8192);
                s0 = MFMA32(a0, qf[ds], s0); s1 = MFMA32(a1, qf[ds], s1);
            }
            if (64 * t + 63 > q0) {
                const int qrel = q0 + r32 - 64 * t - 4 * hh;
#pragma unroll
                for (int r = 0; r < 16; ++r) { const int kv = (r & 3) + 8 * (r >> 2); if (kv > qrel) s0[r] = -INFINITY; if (kv + 32 > qrel) s1[r] = -INFINITY; }
            }
            float mx = fmaxf(s0[0], s1[0]);
#pragma unroll
            for (int r = 1; r < 16; ++r) mx = fmaxf(mx, fmaxf(s0[r], s1[r]));
            mx = swap32_max(mx);
            if (!__all(mx < -150.f)) {
                if (__any(mx > 8.f)) {
                    const float dl = fmaxf(mx, 0.f), al = __builtin_amdgcn_exp2f(-dl);
                    m += dl; l *= al;
                    if (hh == 0) wsf[r32] = al;
#pragma unroll
                    for (int r = 0; r < 16; ++r) { const float ar = wsf[crow(r, hh)]; s0[r] -= dl; s1[r] -= dl;
#pragma unroll
                        for (int d = 0; d < 4; ++d) o[d][r] *= ar; }
                }
                float ps = 0.f;
#pragma unroll
                for (int r = 0; r < 16; ++r) { s0[r] = __builtin_amdgcn_exp2f(s0[r]); s1[r] = __builtin_amdgcn_exp2f(s1[r]); ps += s0[r] + s1[r]; }
                l += ps;
                u32x4 pw[4];
#pragma unroll
                for (int k = 0; k < 2; ++k)
#pragma unroll
                    for (int j = 0; j < 4; ++j) { pw[k][j] = cvtpk(s0[8 * k + 2 * j], s0[8 * k + 2 * j + 1]); pw[2 + k][j] = cvtpk(s1[8 * k + 2 * j], s1[8 * k + 2 * j + 1]); }
                lds_cptr vb = (lds_cptr)(lds + bo + vfo);
#pragma unroll
                for (int d = 0; d < 4; ++d)
#pragma unroll
                    for (int ks = 0; ks < 4; ++ks) {
                        const s16x4 lo = vtr(vb + d * 4096 + ks * 1024), hi = vtr(vb + d * 4096 + ks * 1024 + 512);
                        const bf16x8 vf = (bf16x8){lo[0], lo[1], lo[2], lo[3], hi[0], hi[1], hi[2], hi[3]};
                        o[d] = MFMA32(__builtin_bit_cast(bf16x8, pw[ks]), vf, o[d]);
                    }
            }
        }
        if (it + 1 < T) DA_WRITE(((it + 1) & 1) * DA_BUF);
        __syncthreads();
    }
#undef DA_LOAD
#undef DA_WRITE
    l = swap32_sum(l);
    if (hh == 0) wsf[r32] = 1.f / l;
    float inv[16];
#pragma unroll
    for (int r = 0; r < 16; ++r) inv[r] = wsf[crow(r, hh)];
    LAS float* exch = (LAS float*)lds + qs * 4096;
    if (mp == 1) {
#pragma unroll
        for (int d = 0; d < 4; ++d)
#pragma unroll
            for (int r = 0; r < 16; ++r) exch[(d * 16 + r) * 64 + lane] = o[d][r] * inv[r] * lam;
    }
    __syncthreads();
    LAS float* dimg = (LAS float*)(lds + DA_DIFF);
    if (mp == 0) {
#pragma unroll
        for (int d = 0; d < 4; ++d)
#pragma unroll
            for (int r = 0; r < 16; ++r) dimg[(qs * 32 + crow(r, hh)) * DA_DPITCH + d * 32 + r32] = o[d][r] * inv[r] - exch[(d * 16 + r) * 64 + lane];
    }
    __syncthreads();
    {
        const int row = tid >> 2, qt = tid & 3; const size_t grow = rowbase + qblk * 128 + row;
        f32x4 dv[8]; float ss = 0.f;
#pragma unroll
        for (int i = 0; i < 8; ++i) { dv[i] = *(const LAS f32x4*)(dimg + row * DA_DPITCH + qt * 32 + 4 * i); ss += (dv[i][0] * dv[i][0] + dv[i][1] * dv[i][1]) + (dv[i][2] * dv[i][2] + dv[i][3] * dv[i][3]); }
        ss += __shfl_xor(ss, 1); ss += __shfl_xor(ss, 2);
        const float rn = (1.f - LAMBDA_INIT) / sqrtf(ss * (1.f / 128.f) + EPS);
        const u32x4* gp = (const u32x4*)(proj + grow * PROJ_P + CGA + h * 128 + qt * 32); u32x4* yp = (u32x4*)(Y + grow * ypitch + h * 128 + qt * 32);
        const f32x4* wp = (const f32x4*)(subln + qt * 32);
#pragma unroll
        for (int i = 0; i < 4; ++i) { const u32x4 g = gp[i]; const f32x4 w0 = wp[2 * i], w1 = wp[2 * i + 1], d0 = dv[2 * i], d1 = dv[2 * i + 1]; u32x4 y;
            y.x = cvtpk(d0[0] * rn * w0[0] * silu_fast(bf2f(g.x & 0xffffu)), d0[1] * rn * w0[1] * silu_fast(bf2f(g.x >> 16)));
            y.y = cvtpk(d0[2] * rn * w0[2] * silu_fast(bf2f(g.y & 0xffffu)), d0[3] * rn * w0[3] * silu_fast(bf2f(g.y >> 16)));
            y.z = cvtpk(d1[0] * rn * w1[0] * silu_fast(bf2f(g.z & 0xffffu)), d1[1] * rn * w1[1] * silu_fast(bf2f(g.z >> 16)));
            y.w = cvtpk(d1[2] * rn * w1[2] * silu_fast(bf2f(g.w & 0xffffu)), d1[3] * rn * w1[3] * silu_fast(bf2f(g.w >> 16)));
            yp[i] = y; }
    }
    __syncthreads();
}

constexpr int SW_TILE = 16384, SW_BUF = 3 * SW_TILE, SW_WS = 2 * SW_BUF, SW_STG = SW_WS + 2048, SW_SPITCH = 36;
__device__ __forceinline__ void fast_swa_group(int ug, LAS unsigned char* lds, const bf16_t* projc, const float* sinks, bf16_t* OGb, int opitch) {
    const int tid = threadIdx.x, lane = tid & 63, wave = __builtin_amdgcn_readfirstlane(tid >> 6), r32 = lane & 31, hh = lane >> 5;
    LAS float* wsf = (LAS float*)(lds + SW_WS) + wave * 64;
    LAS float* stg = (LAS float*)(lds + SW_STG) + wave * (32 * SW_SPITCH);
    const int kdst = wave * 1024 + lane * 16, vdst = 8192 + wave * 1024 + lane * 16;
    const int vfo = 8192 + ((lane >> 4) & 1) * 32 + (lane & 3) * 8 + (4 * hh + ((lane & 15) >> 2)) * 64;
    u32x4 kr[3], vr[3];
#define SW_DECODE(u, b_, kvh_, q0_, thi_, nt_) const int b_ = (u) >> 7, kvh_ = ((u) >> 6) & 1, q0_ = ((u) & 63) * 32, thi_ = (q0_ + 31) >> 6, nt_ = thi_ - ((q0_ >= 127) ? ((q0_ - 127) >> 6) : 0) + 1
#define SW_LOAD(u) do { SW_DECODE(u, b_, kvh_, q0_, thi_, nt_); (void)q0_; \
        const bf16_t* ks_ = projc + ((size_t)b_ * SEQ + lane) * ODD_IN + OK_ + kvh_ * 64 + wave * 8; \
        const bf16_t* vs_ = projc + ((size_t)b_ * SEQ + 16 * (wave & 3) + (lane >> 2)) * ODD_IN + OV + kvh_ * 64 + (wave >> 2) * 32 + (lane & 3) * 8; \
        _Pragma("unroll") for (int s_ = 0; s_ < 3; ++s_) if (s_ < nt_) { const size_t to_ = (size_t)(thi_ - s_) * 64 * ODD_IN; kr[s_] = *(const u32x4*)(ks_ + to_); vr[s_] = *(const u32x4*)(vs_ + to_); } } while (0)
#define SW_WRITE(u, bo) do { SW_DECODE(u, b_, kvh_, q0_, thi_, nt_); (void)b_; (void)kvh_; (void)q0_; \
        _Pragma("unroll") for (int s_ = 0; s_ < 3; ++s_) if (s_ < nt_) { *(LAS u32x4*)(lds + (bo) + s_ * SW_TILE + kdst) = kr[s_]; *(LAS u32x4*)(lds + (bo) + s_ * SW_TILE + vdst) = vr[s_]; } } while (0)
    const int u0 = ug * 8;
    SW_LOAD(u0); SW_WRITE(u0, 0);
    __syncthreads();
    for (int i = 0; i < 8; ++i) {
        const int u = u0 + i, bo = (i & 1) * SW_BUF;
        if (i + 1 < 8) SW_LOAD(u + 1);
        {
            SW_DECODE(u, b, kvh, q0, thi, nt);
            const int head = kvh * 8 + wave; const size_t rowbase = (size_t)b * SEQ;
            bf16x8 qf[4];
#pragma unroll
            for (int ds = 0; ds < 4; ++ds) qf[ds] = *(const bf16x8*)(projc + (rowbase + q0 + r32) * ODD_IN + OQ + head * 64 + ds * 16 + hh * 8);
            const float slope2 = exp2f(-0.5f * (float)(head + 1)) * LOG2E, sc2 = 0.125f * LOG2E;
            float m = sinks[head] * LOG2E + slope2 * (float)r32, l = (hh == 0) ? 1.f : 0.f;
            f32x16 o[2];
#pragma unroll
            for (int d = 0; d < 2; ++d)
#pragma unroll
                for (int r = 0; r < 16; ++r) o[d][r] = 0.f;
            for (int s = 0; s < nt; ++s) {
                const int t = thi - s;
                lds_cptr kb = (lds_cptr)(lds + bo + s * SW_TILE + hh * 1024 + r32 * 16);
                f32x16 s0, s1;
#pragma unroll
                for (int r = 0; r < 16; ++r) { s0[r] = 0.f; s1[r] = 0.f; }
#pragma unroll
                for (int ds = 0; ds < 4; ++ds) {
                    const bf16x8 a0 = *(const LAS bf16x8*)(kb + ds * 2048), a1 = *(const LAS bf16x8*)(kb + ds * 2048 + 512);
                    s0 = MFMA32(a0, qf[ds], s0); s1 = MFMA32(a1, qf[ds], s1);
                }
                const float tb = slope2 * (float)(64 * t + 4 * hh - q0);
                const int qrel = q0 + r32 - 64 * t - 4 * hh;
#pragma unroll
                for (int r = 0; r < 16; ++r) { const int kv = (r & 3) + 8 * (r >> 2); const float c = slope2 * (float)kv + tb;
                    s0[r] = (kv > qrel || kv < qrel - 127) ? -INFINITY : s0[r] * sc2 + c;
                    s1[r] = (kv + 32 > qrel || kv + 32 < qrel - 127) ? -INFINITY : s1[r] * sc2 + (c + 32.f * slope2); }
                float mx = fmaxf(s0[0], s1[0]);
#pragma unroll
                for (int r = 1; r < 16; ++r) mx = fmaxf(mx, fmaxf(s0[r], s1[r]));
                mx = swap32_max(mx);
                if (__any(mx > m + 8.f)) {
                    const float mn = fmaxf(m, mx), al = __builtin_amdgcn_exp2f(m - mn);
                    m = mn; l *= al;
                    if (hh == 0) wsf[r32] = al;
#pragma unroll
                    for (int r = 0; r < 16; ++r) { const float ar = wsf[crow(r, hh)]; o[0][r] *= ar; o[1][r] *= ar; }
                }
                float ps = 0.f;
#pragma unroll
                for (int r = 0; r < 16; ++r) { s0[r] = __builtin_amdgcn_exp2f(s0[r] - m); s1[r] = __builtin_amdgcn_exp2f(s1[r] - m); ps += s0[r] + s1[r]; }
                l += ps;
                u32x4 pw[4];
#pragma unroll
                for (int k = 0; k < 2; ++k)
#pragma unroll
                    for (int j = 0; j < 4; ++j) { pw[k][j] = cvtpk(s0[8 * k + 2 * j], s0[8 * k + 2 * j + 1]); pw[2 + k][j] = cvtpk(s1[8 * k + 2 * j], s1[8 * k + 2 * j + 1]); }
                lds_cptr vb = (lds_cptr)(lds + bo + s * SW_TILE + vfo);
#pragma unroll
                for (int d = 0; d < 2; ++d)
#pragma unroll
                    for (int ks = 0; ks < 4; ++ks) {
                        const s16x4 lo = vtr(vb + d * 4096 + ks * 1024), hi = vtr(vb + d * 4096 + ks * 1024 + 512);
                        const bf16x8 vf = (bf16x8){lo[0], lo[1], lo[2], lo[3], hi[0], hi[1], hi[2], hi[3]};
                        o[d] = MFMA32(__builtin_bit_cast(bf16x8, pw[ks]), vf, o[d]);
                    }
            }
            l = swap32_sum(l);
            if (hh == 0) wsf[r32] = 1.f / l;
            float inv[16];
#pragma unroll
            for (int r = 0; r < 16; ++r) inv[r] = wsf[crow(r, hh)];
            const int row = lane >> 1, hf = lane & 1; const size_t grow = rowbase + q0 + row;
#pragma unroll
            for (int d = 0; d < 2; ++d) {
#pragma unroll
                for (int r = 0; r < 16; ++r) stg[crow(r, hh) * SW_SPITCH + r32] = o[d][r] * inv[r];
                const u32x4* gp = (const u32x4*)(projc + grow * ODD_IN + OG_ + head * 64 + d * 32 + hf * 16); u32x4* op = (u32x4*)(OGb + grow * opitch + head * 64 + d * 32 + hf * 16);
#pragma unroll
                for (int i = 0; i < 2; ++i) { const u32x4 g = gp[i]; const f32x4 a0 = *(const LAS f32x4*)(stg + row * SW_SPITCH + hf * 16 + 8 * i), a1 = *(const LAS f32x4*)(stg + row * SW_SPITCH + hf * 16 + 8 * i + 4); u32x4 y;
                    y.x = pk2(a0[0] * silu_f(bf2f(g.x & 0xffffu)), a0[1] * silu_f(bf2f(g.x >> 16))); y.y = pk2(a0[2] * silu_f(bf2f(g.y & 0xffffu)), a0[3] * silu_f(bf2f(g.y >> 16)));
                    y.z = pk2(a1[0] * silu_f(bf2f(g.z & 0xffffu)), a1[1] * silu_f(bf2f(g.z >> 16))); y.w = pk2(a1[2] * silu_f(bf2f(g.w & 0xffffu)), a1[3] * silu_f(bf2f(g.w >> 16)));
                    op[i] = y; }
            }
        }
        if (i + 1 < 8) SW_WRITE(u + 1, ((i + 1) & 1) * SW_BUF);
        __syncthreads();
    }
#undef SW_DECODE
#undef SW_LOAD
#undef SW_WRITE
}

constexpr int SS_BM = 0, SS_CM = 32768, SS_XDT = 65536, SS_XW = 81920, SS_H = 98304, SS_ZT = 114688, SS_ZP = 144, SS_F = 133120;
__device__ __forceinline__ int rowoff_a(int row) { return 2048 * (row >> 3) + 64 * (row & 7); }
__device__ __forceinline__ int off_a(int row, int ch) { return rowoff_a(row) + 512 * (ch >> 2) + 16 * ((ch & 3) ^ ((row >> 2) & 3)); }
__device__ __forceinline__ void fast_ssd_unit(int b, int hd, LAS unsigned char* lds, const bf16_t* proj, const float* dtraw, const float* conv_w, const float* conv_b, const float* dt_bias, const float* a_log,
                                              const float* d_skip, bf16_t* Y, int ypitch, int ycol0, float* ssq) {
    const int tid = threadIdx.x, lane = tid & 63, wave = __builtin_amdgcn_readfirstlane(tid >> 6), r32 = lane & 31, hh = lane >> 5, lb = wave & 3, pb = wave >> 2, g = hd >> 3;
    const size_t rowbase = (size_t)b * SEQ;
    LAS float* fdt = (LAS float*)(lds + SS_F); LAS float* fcs = fdt + 128; LAS float* fecs = fdt + 256;
    LAS float* wl = (LAS float*)(lds + SS_F + 2048);
    const float A2 = -__expf(a_log[hd]) * LOG2E, dtb = dt_bias[hd], Dk = d_skip[hd];
    for (int i = tid; i < 1600; i += 512) { const int j = i / 320, cidx = i % 320; const int ch = (cidx < 128) ? 1024 + g * 128 + cidx : (cidx < 256) ? 1280 + g * 128 + (cidx - 128) : hd * 64 + (cidx - 256);
        wl[i] = (j < 4) ? conv_w[j * 1536 + ch] : conv_b[ch]; }
    f32x16 Hacc;
#pragma unroll
    for (int r = 0; r < 16; ++r) Hacc[r] = 0.f;
    const __amdgpu_buffer_rsrc_t prs = __builtin_amdgcn_make_buffer_rsrc((void*)(proj + rowbase * PROJ_P - 3 * PROJ_P), (short)0, (int)((SEQ + 3) * PROJ_P * 2), 0x00020000);
#define SS_ROLES(t_) const int half = (t_) >> 8, cc1 = (t_) & 15, run = ((t_) & 255) >> 4, cc2 = (t_) & 7, rr2 = (t_) >> 3; \
    const int toff1 = 2 * (8 * run * PROJ_P + CXS + 1024 + half * 256 + g * 128 + cc1 * 8), toff2 = 2 * (2 * rr2 * PROJ_P + CXS + hd * 64 + cc2 * 8), toffz = 2 * (rr2 * PROJ_P + CZ + hd * 64 + cc2 * 8); \
    (void)half; (void)cc1; (void)run; (void)cc2; (void)rr2; (void)toff1; (void)toff2; (void)toffz
    u32x4 raw1[11], raw2[5], zr[2]; float dr0 = 0.f, dr1 = 0.f;
#define SS_BLD(voff, row) __builtin_bit_cast(u32x4, __builtin_amdgcn_raw_buffer_load_b128(prs, (voff), (int)(((row) + 3) * (PROJ_P * 2)), 0))
#define SS_PREFETCH1(cn) do { \
        _Pragma("unroll") for (int i = 0; i < 11; ++i) { const bool ok = ((cn) > 0) || (8 * run + i >= 3); raw1[i] = ok ? SS_BLD(toff1, (cn) * 128 + i - 3) : (u32x4){0u, 0u, 0u, 0u}; } } while (0)
#define SS_PREFETCHD(cn) do { if (wave == 0) { dr0 = dtraw[(rowbase + (size_t)(cn) * 128 + 2 * lane) * 16 + hd]; dr1 = dtraw[(rowbase + (size_t)(cn) * 128 + 2 * lane + 1) * 16 + hd]; } } while (0)
#define SS_PREFETCH2(cn) do { \
        _Pragma("unroll") for (int i = 0; i < 5; ++i) { const bool ok = ((cn) > 0) || (2 * rr2 + i >= 3); raw2[i] = ok ? SS_BLD(toff2, (cn) * 128 + i - 3) : (u32x4){0u, 0u, 0u, 0u}; } \
        zr[0] = SS_BLD(toffz, (cn) * 128); zr[1] = SS_BLD(toffz, (cn) * 128 + 64); } while (0)
#define SS_PART0() do { if (wave == 0) { const float r0 = dr0 + dtb, r1 = dr1 + dtb; \
        const float d0 = (r0 > 20.f) ? r0 : log1pf(__expf(r0)), d1 = (r1 > 20.f) ? r1 : log1pf(__expf(r1)); \
        const float a0 = d0 * A2, a1 = d1 * A2; float s = a0 + a1; \
        _Pragma("unroll") for (int o = 1; o < 64; o <<= 1) { const float t = __shfl_up(s, o); if (lane >= o) s += t; } \
        const float c1 = s, c0 = s - a1; \
        fdt[2 * lane] = d0; fdt[2 * lane + 1] = d1; fcs[2 * lane] = c0; fcs[2 * lane + 1] = c1; fecs[2 * lane] = __builtin_amdgcn_exp2f(c0); fecs[2 * lane + 1] = __builtin_amdgcn_exp2f(c1); } } while (0)
    SS_PREFETCHD(0); SS_PART0();
    { SS_ROLES(tid); SS_PREFETCH1(0); }
    __syncthreads();
    for (int c = 0; c < 16; ++c) {
        const size_t crow0 = rowbase + (size_t)c * 128;
        {
        int tS = threadIdx.x; asm volatile("" : "+v"(tS));
        SS_ROLES(tS);
        SS_PREFETCH2(c);
        {
            f32x4 w[4][2], bs[2];
            LAS const float* wp = wl + half * 128 + cc1 * 8;
#pragma unroll
            for (int j = 0; j < 4; ++j) { w[j][0] = *(const LAS f32x4*)(wp + j * 320); w[j][1] = *(const LAS f32x4*)(wp + j * 320 + 4); }
            bs[0] = *(const LAS f32x4*)(wp + 4 * 320); bs[1] = *(const LAS f32x4*)(wp + 4 * 320 + 4);
            LAS unsigned char* img = lds + (half ? SS_CM : SS_BM) + 2048 * run + 512 * (cc1 >> 2);
#pragma unroll
            for (int r = 0; r < 8; ++r) {
                float v[8];
#pragma unroll
                for (int e = 0; e < 8; ++e) v[e] = bs[e >> 2][e & 3];
#pragma unroll
                for (int j = 0; j < 4; ++j)
#pragma unroll
                    for (int e = 0; e < 4; ++e) { const unsigned wd = raw1[r + j][e]; v[2 * e] += w[j][(2 * e) >> 2][(2 * e) & 3] * bf2f(wd & 0xffffu); v[2 * e + 1] += w[j][(2 * e + 1) >> 2][(2 * e + 1) & 3] * bf2f(wd >> 16); }
                u32x4 o;
#pragma unroll
                for (int e = 0; e < 4; ++e) o[e] = cvtpk(silu_fast(v[2 * e]), silu_fast(v[2 * e + 1]));
                *(LAS u32x4*)(img + 64 * r + 16 * ((cc1 & 3) ^ ((2 * run + (r >> 2)) & 3))) = o;
                __builtin_amdgcn_sched_barrier(0);
            }
        }
        __builtin_amdgcn_sched_barrier(0);
        *(LAS u32x4*)(lds + SS_ZT + rr2 * SS_ZP + cc2 * 16) = zr[0]; *(LAS u32x4*)(lds + SS_ZT + (rr2 + 64) * SS_ZP + cc2 * 16) = zr[1];
        {
            f32x4 w[4][2], bs[2];
            LAS const float* wp = wl + 256 + cc2 * 8;
#pragma unroll
            for (int j = 0; j < 4; ++j) { w[j][0] = *(const LAS f32x4*)(wp + j * 320); w[j][1] = *(const LAS f32x4*)(wp + j * 320 + 4); }
            bs[0] = *(const LAS f32x4*)(wp + 4 * 320); bs[1] = *(const LAS f32x4*)(wp + 4 * 320 + 4);
            const float cl = fcs[127];
#pragma unroll
            for (int r = 0; r < 2; ++r) {
                const int row = 2 * rr2 + r; const float dtv = fdt[row], dec = __builtin_amdgcn_exp2f(cl - fcs[row]);
                float v[8];
#pragma unroll
                for (int e = 0; e < 8; ++e) v[e] = bs[e >> 2][e & 3];
#pragma unroll
                for (int j = 0; j < 4; ++j)
#pragma unroll
                    for (int e = 0; e < 4; ++e) { const unsigned wd = raw2[r + j][e]; v[2 * e] += w[j][(2 * e) >> 2][(2 * e) & 3] * bf2f(wd & 0xffffu); v[2 * e + 1] += w[j][(2 * e + 1) >> 2][(2 * e + 1) & 3] * bf2f(wd >> 16); }
                u32x4 o1, o2;
#pragma unroll
                for (int e = 0; e < 4; ++e) { const unsigned xb = cvtpk(silu_fast(v[2 * e]), silu_fast(v[2 * e + 1])); const float x0 = bf2f(xb & 0xffffu) * dtv, x1 = bf2f(xb >> 16) * dtv; o1[e] = cvtpk(x0, x1); o2[e] = cvtpk(x0 * dec, x1 * dec); }
                const int po = ((cc2 >> 2) * 8 + (row >> 4)) * 1024 + (row & 15) * 64 + (cc2 & 3) * 16;
                *(LAS u32x4*)(lds + SS_XDT + po) = o1; *(LAS u32x4*)(lds + SS_XW + po) = o2;
            }
        }
        __builtin_amdgcn_sched_barrier(0);
        if (c < 15) { SS_PREFETCH1(c + 1); SS_PREFETCHD(c + 1); }
        }
        __syncthreads();
        {
            int tC = threadIdx.x; asm volatile("" : "+v"(tC));
            const int lane = tC & 63, r32 = lane & 31, hh = lane >> 5, blk = (lane >> 4) & 1, q4 = (lane & 15) >> 2, p4 = lane & 3;
            const int xr = (r32 >> 2) & 3, rr0 = rowoff_a(r32) + 16 * (hh ^ xr), rr1 = rowoff_a(r32) + 16 * ((hh ^ xr) ^ 2);
            const int tb0 = 2048 * hh + 512 * lb + 64 * q4 + 16 * ((2 * blk + (p4 >> 1)) ^ ((2 * hh) & 3)) + 8 * (p4 & 1);
            const int tb1 = 2048 * hh + 512 * lb + 64 * (4 + q4) + 16 * ((2 * blk + (p4 >> 1)) ^ ((2 * hh + 1) & 3)) + 8 * (p4 & 1);
            const int vfo = blk * 32 + p4 * 8 + (4 * hh + q4) * 64;
            const int vfn = blk * 32 + p4 * 8 + (8 * hh + q4) * 64;
            const float csl = fcs[32 * lb + r32];
            f32x16 yacc;
#pragma unroll
            for (int r = 0; r < 16; ++r) yacc[r] = 0.f;
            lds_cptr cfr0 = (lds_cptr)(lds + SS_CM + 8192 * lb + rr0), cfr1 = (lds_cptr)(lds + SS_CM + 8192 * lb + rr1);
            for (int sb = 0; sb <= lb; ++sb) {
                f32x16 X;
#pragma unroll
                for (int r = 0; r < 16; ++r) X[r] = 0.f;
                lds_cptr bfr0 = (lds_cptr)(lds + SS_BM + 8192 * sb + rr0), bfr1 = (lds_cptr)(lds + SS_BM + 8192 * sb + rr1);
#pragma unroll
                for (int ks = 0; ks < 8; ++ks) {
                    const bf16x8 af = *(const LAS bf16x8*)(((ks & 1) ? bfr1 : bfr0) + 512 * (ks >> 1)), bq = *(const LAS bf16x8*)(((ks & 1) ? cfr1 : cfr0) + 512 * (ks >> 1));
                    X = MFMA32(af, bq, X);
                }
                LAS const float* csb = fcs + 32 * sb + 4 * hh;
#pragma unroll
                for (int r = 0; r < 16; ++r) { const int si = (r & 3) + 8 * (r >> 2); const bool dead = (sb == lb) && (si + 4 * hh > r32); const float e = dead ? 0.f : __builtin_amdgcn_exp2f(csl - csb[si]); X[r] *= e; }
#pragma unroll
                for (int k2 = 0; k2 < 2; ++k2) {
                    u32x4 pw;
#pragma unroll
                    for (int j = 0; j < 4; ++j) pw[j] = cvtpk(X[8 * k2 + 2 * j], X[8 * k2 + 2 * j + 1]);
                    lds_cptr vb = (lds_cptr)(lds + SS_XDT + (pb * 8 + 2 * sb + k2) * 1024 + vfo);
                    const s16x4 lo = vtr(vb), hi = vtr(vb + 512);
                    const bf16x8 vf = (bf16x8){lo[0], lo[1], lo[2], lo[3], hi[0], hi[1], hi[2], hi[3]};
                    yacc = MFMA32(__builtin_bit_cast(bf16x8, pw), vf, yacc);
                }
            }
            if (c > 0) {
                f32x16 yo;
#pragma unroll
                for (int r = 0; r < 16; ++r) yo[r] = 0.f;
                lds_cptr hfr0 = (lds_cptr)(lds + SS_H + 8192 * pb + rr0), hfr1 = (lds_cptr)(lds + SS_H + 8192 * pb + rr1);
#pragma unroll
                for (int ks = 0; ks < 8; ++ks) {
                    const bf16x8 af = *(const LAS bf16x8*)(((ks & 1) ? cfr1 : cfr0) + 512 * (ks >> 1)), bq = *(const LAS bf16x8*)(((ks & 1) ? hfr1 : hfr0) + 512 * (ks >> 1));
                    yo = MFMA32(af, bq, yo);
                }
                LAS const float* eb = fecs + 32 * lb + 4 * hh;
#pragma unroll
                for (int r = 0; r < 16; ++r) yacc[r] += eb[(r & 3) + 8 * (r >> 2)] * yo[r];
            }
            {
                LAS const float* db_ = fdt + 32 * lb + 4 * hh;
                LAS unsigned char* zt = lds + SS_ZT + (32 * lb + 4 * hh) * SS_ZP + (32 * pb + r32) * 2;
                lds_cptr xe = (lds_cptr)(lds + SS_XDT + (pb * 8 + 2 * lb) * 1024 + (4 * hh) * 64 + r32 * 2);
#pragma unroll
                for (int r = 0; r < 16; ++r) {
                    const int si = (r & 3) + 8 * (r >> 2);
                    const float xdtv = bf2f(*(const LAS unsigned short*)(xe + (si >> 4) * 1024 + (si & 15) * 64));
                    const float y = yacc[r] + (Dk * __builtin_amdgcn_rcpf(db_[si])) * xdtv;
                    const float z = bf2f(*(const LAS unsigned short*)(zt + si * SS_ZP));
                    *(LAS unsigned short*)(zt + si * SS_ZP) = (unsigned short)f2bf(y * silu_fast(z));
                }
            }
            if (c < 15) {
                const float dl = fecs[127];
#pragma unroll
                for (int r = 0; r < 16; ++r) Hacc[r] *= dl;
                lds_cptr xa = (lds_cptr)(lds + SS_XW + pb * 8192 + vfn), b0 = (lds_cptr)(lds + SS_BM + tb0), b1 = (lds_cptr)(lds + SS_BM + tb1);
#pragma unroll
                for (int ks = 0; ks < 8; ++ks) {
                    const s16x4 alo = vtr(xa + ks * 1024), ahi = vtr(xa + ks * 1024 + 256);
                    const s16x4 blo = vtr(b0 + ks * 4096), bhi = vtr(b1 + ks * 4096);
                    const bf16x8 af = (bf16x8){alo[0], alo[1], alo[2], alo[3], ahi[0], ahi[1], ahi[2], ahi[3]}, bq = (bf16x8){blo[0], blo[1], blo[2], blo[3], bhi[0], bhi[1], bhi[2], bhi[3]};
                    Hacc = MFMA32(af, bq, Hacc);
                }
            }
        }
        __syncthreads();
        if (c < 15) {
            LAS unsigned char* hb = lds + SS_H + 8192 * pb + 512 * lb + (r32 & 7) * 2;
#pragma unroll
            for (int r = 0; r < 16; ++r) { const int p = crow(r, hh); *(LAS unsigned short*)(hb + rowoff_a(p) + 16 * (((r32 >> 3) & 3) ^ ((p >> 2) & 3))) = (unsigned short)f2bf(Hacc[r]); }
            SS_PART0();
        }
        {
            const int row = tid >> 2, qt = tid & 3;
            const u32x4 y0 = *(const LAS u32x4*)(lds + SS_ZT + row * SS_ZP + qt * 32), y1 = *(const LAS u32x4*)(lds + SS_ZT + row * SS_ZP + qt * 32 + 16);
            float s = 0.f;
#pragma unroll
            for (int e = 0; e < 4; ++e) { const float a0 = bf2f(y0[e] & 0xffffu), a1 = bf2f(y0[e] >> 16), a2 = bf2f(y1[e] & 0xffffu), a3 = bf2f(y1[e] >> 16); s += (a0 * a0 + a1 * a1) + (a2 * a2 + a3 * a3); }
            s += __shfl_xor(s, 1); s += __shfl_xor(s, 2);
            u32x4* yp = (u32x4*)(Y + (crow0 + row) * ypitch + ycol0 + hd * 64 + qt * 16); yp[0] = y0; yp[1] = y1;
            if (qt == 0) ssq[(crow0 + row) * 16 + hd] = s;
        }
        __syncthreads();
    }
#undef SS_PREFETCH1
#undef SS_ROLES
#undef SS_BLD
#undef SS_PREFETCHD
#undef SS_PREFETCH2
#undef SS_PART0
}

#include <hip/hip_cooperative_groups.h>
namespace cg = cooperative_groups;
#define GAS __attribute__((address_space(1)))
#define LDS_WAIT() asm volatile("s_waitcnt lgkmcnt(0)" ::: "memory")
constexpr int NWAVES = 8, NTHREADS = NWAVES * 64;
constexpr int RING_BYTES = 131072, LDS_BYTES = 147456;
constexpr int NPHASE = 9, LDS_BARW = LDS_BYTES - 64;

typedef GAS unsigned gu32;
#define RLX_AGENT __ATOMIC_RELAXED, __HIP_MEMORY_SCOPE_AGENT
#define XB_TMO      128
#define XB_XCNT(j)  (256  + 64 * (j))
#define XB_XSUB(j)  (1280 + 64 * (j))
#define XB_XGEN(j)  (2304 + 64 * (j))
#define XB_TOP      3328
#define XB_TOPGEN   3392
#define XCD_BAR_WORDS 3456
#define XB_SPIN_CAP (1u << 18)

__device__ __forceinline__ unsigned xb_ld(unsigned* p)              { return __hip_atomic_load(p, __ATOMIC_RELAXED, __HIP_MEMORY_SCOPE_AGENT); }
__device__ __forceinline__ unsigned xb_add(unsigned* p, unsigned v) { return __hip_atomic_fetch_add(p, v, __ATOMIC_RELAXED, __HIP_MEMORY_SCOPE_AGENT); }
__device__ __forceinline__ unsigned xb_xcc_id() { return (unsigned)__builtin_amdgcn_s_getreg((3 << 11) | 20) & 0xFu; }
#define XB_SPIN(cond, bar) do { unsigned _sp = 0; while (cond) { __builtin_amdgcn_s_sleep(1); \
    if ((++_sp & 255u) == 0u) { if (xb_ld(&(bar)[XB_TMO])) break; if (_sp > XB_SPIN_CAP) { atomicAdd(&(bar)[XB_TMO], 1u); break; } } } } while (0)

struct XcdBarrier {
    unsigned* bar; unsigned x;
    volatile LAS unsigned* st;
};

__device__ __forceinline__ XcdBarrier xcd_barrier_post(unsigned* bar, volatile LAS unsigned* st) {
    XcdBarrier b; b.bar = bar; b.x = xb_xcc_id(); b.st = st;
    if (threadIdx.x == 0) (void)xb_add(&bar[XB_XCNT(b.x)], 1u);
    return b;
}
__device__ __forceinline__ void xcd_barrier_complete(unsigned* bar, unsigned x, unsigned& nloc, unsigned& nx) {
    const unsigned G = gridDim.x * gridDim.y * gridDim.z;
    unsigned sum, cnt, mine, sp = 0u;
    for (;;) {
        sum = 0u; cnt = 0u; mine = 0u;
#pragma unroll
        for (unsigned j = 0; j < 16; ++j) { const unsigned c = xb_ld(&bar[XB_XCNT(j)]); sum += c; cnt += (c > 0u) ? 1u : 0u; mine = (j == x) ? c : mine; }
        if (sum == G) break;
        __builtin_amdgcn_s_sleep(1);
        if ((++sp & 255u) == 0u) { if (xb_ld(&bar[XB_TMO])) break; if (sp > XB_SPIN_CAP) { atomicAdd(&bar[XB_TMO], 1u); break; } }
    }
    nloc = mine > 0u ? mine : 1u; nx = cnt > 0u ? cnt : 1u;
}

__device__ __forceinline__ void xcd_barrier(const XcdBarrier& b) {
    asm volatile("s_waitcnt vmcnt(0)" ::: "memory");
    __syncthreads();
    if (threadIdx.x == 0) {
        unsigned* bar = b.bar;
        __builtin_amdgcn_s_waitcnt(0);
        unsigned nloc = b.st[0], nx = b.st[1];
        if (nloc == 0u) { xcd_barrier_complete(bar, b.x, nloc, nx); b.st[0] = nloc; b.st[1] = nx; }
        const unsigned old = xb_add(&bar[XB_XSUB(b.x)], 1u);
        const unsigned gen = old / nloc;
        if (old + 1u == (gen + 1u) * nloc) {
            __builtin_amdgcn_fence(__ATOMIC_RELEASE, "agent");
            asm volatile("s_waitcnt vmcnt(0)" ::: "memory");
            const unsigned og = xb_add(&bar[XB_TOP], 1u);
            const unsigned tg = og / nx;
            if (og + 1u == (tg + 1u) * nx) xb_add(&bar[XB_TOPGEN], 1u);
            else XB_SPIN(xb_ld(&bar[XB_TOPGEN]) == tg, bar);
            __builtin_amdgcn_fence(__ATOMIC_ACQUIRE, "agent");
            xb_add(&bar[XB_XGEN(b.x)], 1u);
            asm volatile("s_waitcnt vmcnt(0)" ::: "memory");
        } else {
            XB_SPIN(xb_ld(&bar[XB_XGEN(b.x)]) == gen, bar);
            __builtin_amdgcn_fence(__ATOMIC_ACQUIRE, "agent");
            asm volatile("s_waitcnt vmcnt(0)" ::: "memory");
        }
    }
    __syncthreads();
}

struct Args { const float* in[21]; float* out; unsigned char* ws; unsigned char* alt; unsigned char* alt2; int ph_lo, ph_hi, fast, altpitch, skip, pad; };

__device__ __forceinline__ void p0_transpose_item(const float* W, const float* s, int K, int N, bf16_t* WT, LAS float* scr, int item, int nblk, int lane) {
    const int kb = item / nblk, nb = item % nblk, k0 = 64 * kb, n0 = 32 * nb, n = n0 + (lane & 31);
    const bool ok = n < N;
#pragma unroll 8
    for (int i = 0; i < 32; ++i) { const int kk = 2 * i + (lane >> 5); float v = ok ? W[(size_t)(k0 + kk) * N + n] : 0.f; if (s) v *= s[k0 + kk]; scr[kk * 33 + (lane & 31)] = v; }
    LDS_WAIT(); asm volatile("" ::: "memory");
    const int c = lane & 7;
#pragma unroll
    for (int j = 0; j < 4; ++j) { const int nn = (lane >> 3) + 8 * j; const LAS float* sp = scr + (8 * c) * 33 + nn;
        u32x4 o; o.x = pk2(sp[0 * 33], sp[1 * 33]); o.y = pk2(sp[2 * 33], sp[3 * 33]); o.z = pk2(sp[4 * 33], sp[5 * 33]); o.w = pk2(sp[6 * 33], sp[7 * 33]);
        *(u32x4*)(WT + (size_t)(n0 + nn) * K + k0 + 8 * c) = o; }
    LDS_WAIT(); asm volatile("" ::: "memory");
}

__global__ void __launch_bounds__(NTHREADS, 2) mega(Args a) {
    extern __shared__ __attribute__((aligned(16))) unsigned char lds[];
    cg::grid_group grid = cg::this_grid();
    const int tid = threadIdx.x, lane = tid & 63, wave = __builtin_amdgcn_readfirstlane(tid >> 6);
    const int G = gridDim.x, bx = blockIdx.x, vcu = (G % 8 == 0) ? (bx % 8) * (G / 8) + bx / 8 : bx;
    const int gw = vcu * NWAVES + wave, NGW = G * NWAVES;
    unsigned char* ws = a.ws;
    const float* x = a.in[0];
    bf16_t* WA = (bf16_t*)(ws + WS_WA); bf16_t* WOA = (bf16_t*)(ws + WS_WOA); bf16_t* WC = (bf16_t*)(ws + WS_WC); bf16_t* WOC = (bf16_t*)(ws + WS_WOC);
    float* DT = (float*)(ws + WS_DT); float* SSQ = (float*)(ws + WS_SSQ); float* RSTD0 = (float*)(ws + WS_RSTD0); float* SSQ1 = (float*)(ws + WS_SSQ1);
    bf16_t* PROJ = (bf16_t*)(ws + WS_PROJ); float* X1 = (float*)(ws + WS_X1); bf16_t* XB1 = (bf16_t*)(ws + WS_XB1); bf16_t* PROJC = (bf16_t*)(ws + WS_PROJC); bf16_t* OGb = (bf16_t*)(ws + WS_OG);
    bf16_t* XB = (bf16_t*)a.out; bf16_t* Y = (bf16_t*)a.out;
    const int lo = a.ph_lo, hi = a.ph_hi;
#define IN(k) (lo <= (k) && (k) < hi)
#define SEAM(k) do { if (IN(k) && IN((k) + 1)) { if (!bar_ready) { grid.sync(); bar = xcd_barrier_post(barw, (volatile LAS unsigned*)((LAS unsigned char*)lds + LDS_BARW)); bar_ready = true; } else xcd_barrier(bar); } } while (0)
    unsigned* barw = (unsigned*)(ws + WS_CTL + 4096);
    for (int i = tid; i < XCD_BAR_WORDS; i += NTHREADS) if (bx == 0) __hip_atomic_store(barw + i, 0u, RLX_AGENT);
    if (tid < 2) *((LAS unsigned*)((LAS unsigned char*)lds + LDS_BARW) + tid) = 0u;
    __syncthreads();
    XcdBarrier bar; bar.bar = barw; bar.x = 0; bar.st = nullptr; bool bar_ready = false;
#define REP(k) for (int rep_ = 0; rep_ <= ((REP_MASK >> (k)) & 1); ++rep_)

    if (IN(0)) REP(0) {
        LAS float* scr = (LAS float*)((LAS unsigned char*)lds + wave * 16384);
        constexpr int I_A = (DM / 64) * (NA_PAD / 32), I_OA = (2048 / 64) * (DM / 32), I_C = (DM / 64) * (ODD_IN / 32), I_OC = (DM / 64) * (DM / 32);
        for (int it = gw; it < I_A + I_OA + I_C + I_OC; it += NGW) {
            int r = it;
            if (r < I_A) { p0_transpose_item(a.in[2], a.in[1], DM, EVEN_IN, WA, scr, r, NA_PAD / 32, lane); continue; } r -= I_A;
            if (r < I_OA) { p0_transpose_item(a.in[14], nullptr, 2048, DM, WOA, scr, r, DM / 32, lane); continue; } r -= I_OA;
            if (r < I_C) { p0_transpose_item(a.in[16], a.in[15], DM, ODD_IN, WC, scr, r, ODD_IN / 32, lane); continue; } r -= I_C;
            p0_transpose_item(a.in[19], nullptr, DM, DM, WOC, scr, r, DM / 32, lane);
        }
        for (int m0 = gw; m0 < MROWS; m0 += 4 * NGW) {
            f32x4 v[4][4];
#pragma unroll
            for (int q = 0; q < 4; ++q) { const int m = m0 + q * NGW; if (m < MROWS) { const f32x4* xr = (const f32x4*)(x + (size_t)m * DM) + lane;
#pragma unroll
                for (int j = 0; j < 4; ++j) v[q][j] = __builtin_nontemporal_load(xr + 64 * j); } }
#pragma unroll
            for (int q = 0; q < 4; ++q) { const int m = m0 + q * NGW; if (m < MROWS) { float s = 0.f;
                unsigned long long* o8 = (unsigned long long*)(XB + (size_t)m * DM) + lane;
#pragma unroll
                for (int j = 0; j < 4; ++j) { const f32x4 w = v[q][j]; s += (w.x * w.x + w.y * w.y) + (w.z * w.z + w.w * w.w); o8[64 * j] = (unsigned long long)pk2(w.x, w.y) | ((unsigned long long)pk2(w.z, w.w) << 32); }
                s = wave_sum(s);
                if (lane == 0) RSTD0[m] = 1.f / sqrtf(s * (1.f / DM) + EPS); } }
        }
    }
    SEAM(0);
    if (IN(1)) REP(1) {
        pg8::Gemm g{XB, WA, MROWS, NA_PAD, DM}; pg8::StaticOrder S; S.init(MROWS, NA_PAD, G, bx);
        pg8::EpiProjA E{PROJ, DT, RSTD0, PROJ_P, PROJ_P / 256, 4, 0.125f * LOG2E};
        pg8::gemm_phase<pg8::EpiProjA, pg8::StaticOrder, true, true>((LAS unsigned char*)lds, g, S, E);
    }
    SEAM(1);
    if (IN(2)) {
        if (a.skip & 1) { }
        else if (a.fast & 1) REP(2) {
            float s1 = 0.f, s2 = 0.f; for (int i = 0; i < 64; ++i) { s1 += a.in[9][i] * a.in[10][i]; s2 += a.in[11][i] * a.in[12][i]; }
            const float lam = __expf(s1) - __expf(s2) + LAMBDA_INIT;
            bf16_t* Yo = a.alt ? (bf16_t*)a.alt : Y; const int yp = a.alt ? a.altpitch : 2048;
            for (int ug = vcu; ug < 256; ug += G) { const int grp = ug >> 4, j = ug & 15;
                for (int s = 0; s < 8; ++s) { const int bh = grp * 8 + s, qblk = (s & 1) ? 15 - j : j; fast_diffattn_unit(bh >> 3, bh & 7, qblk, (LAS unsigned char*)lds, PROJ, lam, a.in[13], Yo, yp); } }
        } else
        for (int u = bx; u < 2048; u += G) slow_diffattn_unit(u, tid, PROJ, a.in[9], a.in[10], a.in[11], a.in[12], a.in[13], Y);
        if (a.skip & 2) { }
        else if (a.fast & 2) REP(3) { const bool dbg = a.alt2 != nullptr; bf16_t* Yo = dbg ? (bf16_t*)a.alt : Y;
            for (int u = vcu; u < 256; u += G) fast_ssd_unit(u >> 4, u & 15, (LAS unsigned char*)lds, PROJ, DT, a.in[3], a.in[4], a.in[5], a.in[6], a.in[7], Yo, dbg ? a.altpitch : 2048, dbg ? 0 : 1024, dbg ? (float*)a.alt2 : SSQ); }
        else
        for (int pr = bx; pr < 128; pr += G) slow_ssd_pair(pr, tid, (LAS float*)lds, PROJ, DT, a.in[3], a.in[4], a.in[5], a.in[6], a.in[7], Y, SSQ);
    }
    SEAM(2);
    if (IN(3)) {
        const float* w = a.in[8];
        f32x4 wv[2][2];
#pragma unroll
        for (int g = 0; g < 2; ++g) { wv[g][0] = *(const f32x4*)(w + g * 512 + lane * 8); wv[g][1] = *(const f32x4*)(w + g * 512 + lane * 8 + 4); }
        for (int m0 = gw; m0 < MROWS; m0 += 4 * NGW) {
            u32x4 yv[4][2]; f32x4 sv[4][4];
#pragma unroll
            for (int q = 0; q < 4; ++q) { const int m = m0 + q * NGW; if (m < MROWS) {
#pragma unroll
                for (int g = 0; g < 2; ++g) yv[q][g] = *((const u32x4*)(Y + (size_t)m * 2048 + 1024 + g * 512) + lane);
#pragma unroll
                for (int i = 0; i < 4; ++i) sv[q][i] = *((const f32x4*)(SSQ + (size_t)m * 16) + i); } }
#pragma unroll
            for (int q = 0; q < 4; ++q) { const int m = m0 + q * NGW; if (m < MROWS) {
#pragma unroll
                for (int g = 0; g < 2; ++g) {
                    const f32x4 sa = sv[q][2 * g], sb = sv[q][2 * g + 1];
                    const float s = sa[0] + sa[1] + sa[2] + sa[3] + sb[0] + sb[1] + sb[2] + sb[3];
                    const float r = 1.f / sqrtf(s * (1.f / 512.f) + EPS);
                    u32x4 v = yv[q][g];
#pragma unroll
                    for (int i = 0; i < 4; ++i) v[i] = pk2(bf2f(v[i] & 0xffffu) * r * wv[g][i >> 1][(2 * i) & 3], bf2f(v[i] >> 16) * r * wv[g][i >> 1][(2 * i + 1) & 3]);
                    *((u32x4*)(Y + (size_t)m * 2048 + 1024 + g * 512) + lane) = v;
                } } }
        }
    }
    SEAM(3);
    if (IN(4)) {
        pg8::Gemm g{Y, WOA, MROWS, DM, 2048}; pg8::StaticOrder S; S.init(MROWS, DM, G, bx);
        pg8::EpiRes E{x, X1, XB1, SSQ1, DM};
        pg8::gemm_phase<pg8::EpiRes, pg8::StaticOrder, true, true>((LAS unsigned char*)lds, g, S, E);
    }
    SEAM(4);
    if (IN(5)) REP(5) {
        pg8::Gemm g{XB1, WC, MROWS, ODD_IN, DM}; pg8::StaticOrder S; S.init(MROWS, ODD_IN, G, bx);
        pg8::EpiProjC E{PROJC, SSQ1, a.in[17], ODD_IN, 1.f / DM, EPS};
        pg8::gemm_phase<pg8::EpiProjC, pg8::StaticOrder, true, true>((LAS unsigned char*)lds, g, S, E);
    }
    SEAM(5);
    if (IN(6)) {
        if (a.fast & 4) REP(6) { bf16_t* Oo = a.alt ? (bf16_t*)a.alt : OGb; const int op = a.alt ? a.altpitch : DM;
            for (int ug = vcu; ug < 256; ug += G) fast_swa_group(ug, (LAS unsigned char*)lds, PROJC, a.in[18], Oo, op); }
        else
        for (int u = bx; u < 1024; u += G) slow_swa_unit(u, tid, PROJC, a.in[18], OGb);
    }
    SEAM(6);
    if (IN(7)) {
        pg8::Gemm g{OGb, WOC, MROWS, DM, DM}; pg8::StaticOrder S; S.init(MROWS, DM, G, bx);
        pg8::EpiRes E{X1, X1, nullptr, nullptr, DM};
        pg8::gemm_phase<pg8::EpiRes, pg8::StaticOrder, true, true>((LAS unsigned char*)lds, g, S, E);
    }
    SEAM(7);
    if (IN(8)) REP(8) {
        const f32x4* wr = (const f32x4*)a.in[20] + lane;
        const f32x4 w0 = wr[0], w1 = wr[64], w2 = wr[128], w3 = wr[192];
        for (int m0 = gw; m0 < MROWS; m0 += 4 * NGW) {
            f32x4 v[4][4];
#pragma unroll
            for (int q = 0; q < 4; ++q) { const int m = m0 + q * NGW; if (m < MROWS) { const f32x4* xr = (const f32x4*)(X1 + (size_t)m * DM) + lane;
#pragma unroll
                for (int j = 0; j < 4; ++j) v[q][j] = __builtin_nontemporal_load(xr + 64 * j); } }
#pragma unroll
            for (int q = 0; q < 4; ++q) { const int m = m0 + q * NGW; if (m < MROWS) { float s = 0.f;
#pragma unroll
                for (int j = 0; j < 4; ++j) s += (v[q][j].x * v[q][j].x + v[q][j].y * v[q][j].y) + (v[q][j].z * v[q][j].z + v[q][j].w * v[q][j].w);
                s = wave_sum(s); const float r = 1.f / sqrtf(s * (1.f / DM) + EPS);
                f32x4* o = (f32x4*)(a.out + (size_t)m * DM) + lane;
                __builtin_nontemporal_store(v[q][0] * r * w0, o); __builtin_nontemporal_store(v[q][1] * r * w1, o + 64); __builtin_nontemporal_store(v[q][2] * r * w2, o + 128); __builtin_nontemporal_store(v[q][3] * r * w3, o + 192); } }
        }
    }
#undef IN
#undef SEAM
#undef REP
}

#ifndef DEBUG_CMP
#define DEBUG_CMP 0
#endif
#ifndef FAST_MASK
#define FAST_MASK 7
#endif
#ifndef CMP_R0
#define CMP_R0 0
#define CMP_R1 2048
#define CMP_C0 0
#define CMP_C1 1024
#endif
constexpr size_t WS_ALT = 448 * MiB;
__global__ void __launch_bounds__(256) k_cmp_bf16(const bf16_t* A, int pa, const bf16_t* B, int pb, int ncol, int r0, int r1, int c0, int c1, float* met) {
    float sd = 0.f, sr = 0.f;
    for (size_t i = (size_t)blockIdx.x * 256 + threadIdx.x; i < (size_t)MROWS * ncol; i += (size_t)gridDim.x * 256) {
        const int row = (int)(i / ncol), col = (int)(i % ncol), sp = row % SEQ;
        if (sp < r0 || sp >= r1 || col < c0 || col >= c1) continue;
        const float x = bf2f(A[(size_t)row * pa + col]), y = bf2f(B[(size_t)row * pb + col]); const float d = x - y;
        sd += (d == d) ? d * d : 1e6f; sr += x * x;
    }
    sd = wave_sum(sd); sr = wave_sum(sr);
    if ((threadIdx.x & 63) == 0) { atomicAdd(met, sd); atomicAdd(met + 1, sr); }
}
__global__ void __launch_bounds__(256) k_inject(float* out, const float* met) {
    const float rel = fminf(sqrtf(met[0] / fmaxf(met[1], 1e-30f)), 3.f);
    f32x4* o = (f32x4*)out + (size_t)blockIdx.x * 256 + threadIdx.x; *o = *o * (1.f + rel);
}
static int g_grid = 0;
static void launch_mega(const Args& base, int lo, int hi, hipStream_t stream) {
    Args a = base; a.ph_lo = lo; a.ph_hi = hi; void* params[] = {&a};
    hipError_t e = hipLaunchCooperativeKernel((const void*)mega, dim3(g_grid), dim3(NTHREADS), params, LDS_BYTES, stream);
    if (e != hipSuccess) fprintf(stderr, "kernel_launch: cooperative launch [%d,%d) failed: %s (grid %d)\n", lo, hi, hipGetErrorString(e), g_grid);
}
extern "C" void kernel_launch(void* const* d_in, const int* in_sizes, int n_in, void* d_out, int out_size, void* d_ws, size_t ws_size, hipStream_t stream) {
    if (n_in != 21 || in_sizes[0] != MROWS * DM || out_size != MROWS * DM || ws_size < WS_END) { fprintf(stderr, "kernel_launch: unexpected shapes (n_in %d, ws %zu)\n", n_in, ws_size); return; }
    if (g_grid == 0) {
        int dev = 0, cus = 0, per_cu = 0;
        (void)hipGetDevice(&dev); (void)hipDeviceGetAttribute(&cus, hipDeviceAttributeMultiprocessorCount, dev);
        if (hipFuncSetAttribute((const void*)mega, hipFuncAttributeMaxDynamicSharedMemorySize, LDS_BYTES) != hipSuccess) { fprintf(stderr, "kernel_launch: hipFuncSetAttribute failed\n"); g_grid = -1; return; }
        if (hipOccupancyMaxActiveBlocksPerMultiprocessor(&per_cu, (const void*)mega, NTHREADS, LDS_BYTES) != hipSuccess || per_cu < 1) { fprintf(stderr, "kernel_launch: occupancy query says %d blocks per CU\n", per_cu); g_grid = -1; return; }
        g_grid = cus;
        fprintf(stderr, "kernel_launch: %d CUs, %d blocks/CU admitted, grid %d\n", cus, per_cu, g_grid);
    }
    if (g_grid < 0) return;
    unsigned char* ws = (unsigned char*)d_ws;
    Args a{}; for (int i = 0; i < 21; ++i) a.in[i] = (const float*)d_in[i];
    a.out = (float*)d_out; a.ws = ws; a.fast = FAST_MASK;
#if DEBUG_CMP == 0
    launch_mega(a, 0, NPHASE, stream);
#else
    float* met = (float*)(ws + WS_CTL);
    (void)hipMemsetAsync(met, 0, 256, stream);
    a.fast = 0; launch_mega(a, 0, 3, stream);
    Args f = a; f.fast = FAST_MASK;
#if DEBUG_CMP == 1
    f.alt = ws + WS_ALT; f.altpitch = 1024; launch_mega(f, 2, 3, stream);
    k_cmp_bf16<<<1024, 256, 0, stream>>>((const bf16_t*)d_out, 2048, (const bf16_t*)(ws + WS_ALT), 1024, 1024, CMP_R0, CMP_R1, CMP_C0, CMP_C1, met);
#endif
#if DEBUG_CMP == 2
    f.alt = ws + WS_ALT; f.altpitch = 1024; f.alt2 = ws + WS_RSTD0; f.skip = 1; launch_mega(f, 2, 3, stream);
    k_cmp_bf16<<<1024, 256, 0, stream>>>((const bf16_t*)d_out + 1024, 2048, (const bf16_t*)(ws + WS_ALT), 1024, 1024, CMP_R0, CMP_R1, CMP_C0, CMP_C1, met);
#endif
    launch_mega(a, 3, NPHASE, stream);
    k_inject<<<MROWS * DM / 4 / 256, 256, 0, stream>>>((float*)d_out, met);
#endif
}
```

```cpp
#include <hip/hip_runtime.h>
#include <cstdio>
#include <cstdint>
#include <cmath>

typedef unsigned short bf16_t;
typedef unsigned u32x4 __attribute__((ext_vector_type(4)));
typedef float f32x4 __attribute__((ext_vector_type(4)));

constexpr int BATCH = 16, SEQ = 2048, DM = 1024, MROWS = BATCH * SEQ;
constexpr int EVEN_IN = 6672, PROJ_P = 6656, NA_PAD = 6912;
constexpr int CQ = 0, CK = 1024, CV = 2048, CGA = 3072, CZ = 4096, CXS = 5120, CBM = 6144, CCM = 6400, CDT = 6656;
constexpr int ODD_IN = 2304;
constexpr int OQ = 0, OK_ = 1024, OV = 1152, OG_ = 1280;
constexpr float EPS = 1e-5f;
constexpr float LAMBDA_INIT = 0.2f;
constexpr float LOG2E = 1.4426950408889634f;
#ifndef REP_MASK
#define REP_MASK 0
#endif

constexpr size_t MiB = 1u << 20;
constexpr size_t WS_CTL = 0;
constexpr size_t WS_WA = 1 * MiB;
constexpr size_t WS_WOA = 15 * MiB;
constexpr size_t WS_WC = 19 * MiB;
constexpr size_t WS_WOC = 24 * MiB;
constexpr size_t WS_DT = 26 * MiB;
constexpr size_t WS_SSQ = 28 * MiB;
constexpr size_t WS_RSTD0 = 30 * MiB;
constexpr size_t WS_RSTD1 = 30 * MiB + 256 * 1024;
constexpr size_t WS_SSQ1 = WS_DT;
constexpr size_t WS_PROJ = 32 * MiB;
constexpr size_t WS_X1 = 32 * MiB;
constexpr size_t WS_XB1 = 160 * MiB;
constexpr size_t WS_PROJC = 224 * MiB;
constexpr size_t WS_OG = 368 * MiB;
constexpr size_t WS_BC = 448 * MiB;
constexpr size_t WS_END = 480 * MiB;

__device__ __forceinline__ unsigned f2bf(float f) { unsigned u = __builtin_bit_cast(unsigned, f); return (u + 0x7fffu + ((u >> 16) & 1u)) >> 16; }
__device__ __forceinline__ float bf2f(unsigned h) { return __builtin_bit_cast(float, h << 16); }
__device__ __forceinline__ unsigned pk2(float lo, float hi) { return f2bf(lo) | (f2bf(hi) << 16); }
__device__ __forceinline__ float silu_f(float v) { return v / (1.f + __expf(-v)); }
__device__ __forceinline__ float wave_sum(float v) {
#pragma unroll
    for (int o = 1; o < 64; o <<= 1) v += __shfl_xor(v, o);
    return v;
}

#define LAS __attribute__((address_space(3)))
__device__ __forceinline__ void slow_diffattn_unit(int unit, int tid, const bf16_t* proj, const float* lq1, const float* lk1, const float* lq2, const float* lk2, const float* subln, bf16_t* Y) {
    const int qb = unit & 15, h = (unit >> 4) & 7, b = unit >> 7, qi = tid >> 2, eq = tid & 3;
    const int qpos = qb * 128 + qi; const size_t row = (size_t)b * SEQ + qpos;
    float s1 = 0.f, s2 = 0.f; for (int i = 0; i < 64; ++i) { s1 += lq1[i] * lk1[i]; s2 += lq2[i] * lk2[i]; }
    const float lam = __expf(s1) - __expf(s2) + LAMBDA_INIT;
    const float slope = exp2f(-(float)(h + 1));
    float q0[16], q1[16];
    { const bf16_t* qp = proj + row * PROJ_P + CQ + h * 128 + eq * 16;
#pragma unroll
      for (int i = 0; i < 16; ++i) { q0[i] = bf2f(qp[i]); q1[i] = bf2f(qp[64 + i]); } }
    float o0[32], o1[32];
#pragma unroll
    for (int i = 0; i < 32; ++i) { o0[i] = 0.f; o1[i] = 0.f; }
    float m0 = -INFINITY, m1 = -INFINITY, l0 = 0.f, l1 = 0.f;
    const int jmax = qb * 128 + 127;
    for (int j = 0; j <= jmax; ++j) {
        const bf16_t* kp = proj + ((size_t)b * SEQ + j) * PROJ_P + CK + h * 128 + eq * 16;
        float d0 = 0.f, d1 = 0.f;
#pragma unroll
        for (int i = 0; i < 16; ++i) { d0 += q0[i] * bf2f(kp[i]); d1 += q1[i] * bf2f(kp[64 + i]); }
        d0 += __shfl_xor(d0, 1); d0 += __shfl_xor(d0, 2); d1 += __shfl_xor(d1, 1); d1 += __shfl_xor(d1, 2);
        if (j <= qpos) {
            const float bias = slope * (float)(qpos - j);
            const float a0 = d0 * (1.f / LOG2E) - bias, a1 = d1 * (1.f / LOG2E) - bias;
            const float n0 = fmaxf(m0, a0), n1 = fmaxf(m1, a1);
            const float c0 = __expf(m0 - n0), c1 = __expf(m1 - n1), p0 = __expf(a0 - n0), p1 = __expf(a1 - n1);
            m0 = n0; m1 = n1; l0 = l0 * c0 + p0; l1 = l1 * c1 + p1;
            const bf16_t* vp = proj + ((size_t)b * SEQ + j) * PROJ_P + CV + h * 128 + eq * 32;
#pragma unroll
            for (int i = 0; i < 32; ++i) { const float v = bf2f(vp[i]); o0[i] = o0[i] * c0 + p0 * v; o1[i] = o1[i] * c1 + p1 * v; }
        }
    }
    const float i0 = 1.f / l0, i1 = lam / l1; float ss = 0.f;
#pragma unroll
    for (int i = 0; i < 32; ++i) { o0[i] = o0[i] * i0 - o1[i] * i1; ss += o0[i] * o0[i]; }
    ss += __shfl_xor(ss, 1); ss += __shfl_xor(ss, 2);
    const float r = (1.f - LAMBDA_INIT) / sqrtf(ss * (1.f / 128.f) + EPS);
    const bf16_t* gp = proj + row * PROJ_P + CGA + h * 128 + eq * 32; bf16_t* yp = Y + row * 2048 + h * 128 + eq * 32;
#pragma unroll
    for (int i = 0; i < 32; ++i) yp[i] = (bf16_t)f2bf(o0[i] * r * subln[eq * 32 + i] * silu_f(bf2f(gp[i])));
}

__device__ __forceinline__ void slow_ssd_pair(int pair, int tid, LAS float* sm, const bf16_t* proj, const float* dtraw, const float* conv_w, const float* conv_b, const float* dt_bias, const float* a_log,
                                              const float* d_skip, bf16_t* Y, float* ssq) {
    const int half = tid >> 8, t = tid & 255, unit = pair * 2 + half, hd = unit & 15, b = unit >> 4, g = hd >> 3, p = t >> 2, nq = t & 3;
    LAS float* sB = sm + half * 272; LAS float* sC = sB + 128; LAS float* sRed = sB + 256;
    const int cbc = (t < 128) ? (1024 + g * 128 + t) : (1024 + 256 + g * 128 + (t - 128));
    const int cx = hd * 64 + p;
    float wbc[4], wx[4];
#pragma unroll
    for (int j = 0; j < 4; ++j) { wbc[j] = conv_w[j * 1536 + cbc]; wx[j] = conv_w[j * 1536 + cx]; }
    const float bbc = conv_b[cbc], bx = conv_b[cx];
    const float A = -__expf(a_log[hd]), dtb = dt_bias[hd], Dk = d_skip[hd];
    float hbc[3] = {0.f, 0.f, 0.f}, hx[3] = {0.f, 0.f, 0.f};
    float st[32];
#pragma unroll
    for (int i = 0; i < 32; ++i) st[i] = 0.f;
    for (int ts = 0; ts < SEQ; ++ts) {
        const size_t row = (size_t)b * SEQ + ts; const bf16_t* pr = proj + row * PROJ_P;
        const float rbc = bf2f(pr[CXS + cbc]);
        const float vbc = silu_f(wbc[0] * hbc[0] + wbc[1] * hbc[1] + wbc[2] * hbc[2] + wbc[3] * rbc + bbc);
        hbc[0] = hbc[1]; hbc[1] = hbc[2]; hbc[2] = rbc;
        if (t < 128) sB[t] = bf2f(f2bf(vbc)); else sC[t - 128] = bf2f(f2bf(vbc));
        const float rx = bf2f(pr[CXS + cx]);
        const float vx = bf2f(f2bf(silu_f(wx[0] * hx[0] + wx[1] * hx[1] + wx[2] * hx[2] + wx[3] * rx + bx)));
        hx[0] = hx[1]; hx[1] = hx[2]; hx[2] = rx;
        const float dr = dtraw[row * 16 + hd] + dtb; const float dt = (dr > 20.f) ? dr : log1pf(__expf(dr));
        const float dec = __expf(dt * A), dtx = dt * vx;
        __syncthreads();
        float y = 0.f;
#pragma unroll
        for (int i = 0; i < 32; ++i) { st[i] = st[i] * dec + dtx * sB[nq * 32 + i]; y += sC[nq * 32 + i] * st[i]; }
        y += __shfl_xor(y, 1); y += __shfl_xor(y, 2);
        const float z = bf2f(pr[CZ + hd * 64 + p]);
        const float yz = (y + Dk * vx) * silu_f(z);
        float q = (nq == 0) ? yz * yz : 0.f; q = wave_sum(q);
        if ((t & 63) == 0) sRed[t >> 6] = q;
        if (nq == 0) Y[row * 2048 + 1024 + hd * 64 + p] = (bf16_t)f2bf(yz);
        __syncthreads();
        if (t == 0) ssq[row * 16 + hd] = sRed[0] + sRed[1] + sRed[2] + sRed[3];
    }
}
__device__ __forceinline__ void slow_swa_unit(int unit, int tid, const bf16_t* projc, const float* sinks, bf16_t* OGb) {
    const int qpos = (unit & 3) * 512 + tid, h = (unit >> 2) & 15, b = unit >> 6, kvh = h >> 3;
    const size_t row = (size_t)b * SEQ + qpos;
    const float slope = exp2f(-0.5f * (float)(h + 1));
    float q[64], o[64];
    { const bf16_t* qp = projc + row * ODD_IN + OQ + h * 64;
#pragma unroll
      for (int i = 0; i < 64; ++i) { q[i] = bf2f(qp[i]); o[i] = 0.f; } }
    float m = sinks[h], l = 1.f;
    const int j0 = (qpos - 127 > 0) ? qpos - 127 : 0;
    for (int j = j0; j <= qpos; ++j) {
        const bf16_t* kp = projc + ((size_t)b * SEQ + j) * ODD_IN + OK_ + kvh * 64; float d = 0.f;
#pragma unroll
        for (int i = 0; i < 64; ++i) d += q[i] * bf2f(kp[i]);
        const float a = d * (1.f / LOG2E) - slope * (float)(qpos - j);
        const float n = fmaxf(m, a), c = __expf(m - n), p = __expf(a - n);
        m = n; l = l * c + p;
        const bf16_t* vp = projc + ((size_t)b * SEQ + j) * ODD_IN + OV + kvh * 64;
#pragma unroll
        for (int i = 0; i < 64; ++i) o[i] = o[i] * c + p * bf2f(vp[i]);
    }
    const float il = 1.f / l; const bf16_t* gp = projc + row * ODD_IN + OG_ + h * 64; bf16_t* op = OGb + row * DM + h * 64;
#pragma unroll
    for (int i = 0; i < 64; ++i) op[i] = (bf16_t)f2bf(o[i] * il * silu_f(bf2f(gp[i])));
}

namespace pg8 {
#define PG8_LAS __attribute__((address_space(3)))
typedef unsigned short bf16_t;
typedef short bf16x8 __attribute__((ext_vector_type(8)));
typedef float f32x4 __attribute__((ext_vector_type(4)));
typedef unsigned u32x4 __attribute__((ext_vector_type(4)));
constexpr int BM = 256, BK = 64, HALF = 128, HTB = HALF * BK * 2  , STAGE_BYTES = 8 * HTB, NXCD = 8, WGM = 8;

__host__ __device__ __forceinline__ int lds_byte(int r, int c) { const int st = (r >> 4) * 2 + (c >> 5), rr = r & 15, cc = c & 31, ob = rr * 64 + cc * 2; return st * 1024 + (ob ^ (((ob >> 9) & 1) << 5)); }
__host__ __device__ __forceinline__ void stage_rc(int b, int& R, int& C) { const int st = b / 1024, sb = b % 1024, swz = sb ^ (((sb >> 9) & 1) << 5); R = (st >> 1) * 16 + swz / 64; C = (st & 1) * 32 + (swz % 64) / 2; }
__host__ __device__ __forceinline__ int perm32(int rho) { const int n = rho >> 4, i = rho & 15; return 8 * (i >> 2) + 4 * n + (i & 3); }

struct Unit { int pm, pn; };
struct Gemm { const bf16_t* A; const bf16_t* Bt; int M, N, K; };

struct StaticOrder {
    int nM, nN, nwg, G, c;
    __host__ __device__ void init(int M, int N, int G_, int c_) { nM = M / BM; nN = N / BM; nwg = nM * nN; G = G_; c = c_; }
    __host__ __device__ bool next(int i, Unit& u) const {
        const long L = (long)i * G + c; if (L >= nwg) return false;
        int wgid = (int)L; { const int q = nwg / NXCD, r = nwg % NXCD, xcd = wgid % NXCD, off = wgid / NXCD; wgid = (xcd < r ? xcd * (q + 1) : r * (q + 1) + (xcd - r) * q) + off; }
        const int nig = WGM * nN, gid = wgid / nig, fm = gid * WGM, gsz = (nM - fm) < WGM ? (nM - fm) : WGM;
        u.pm = fm + ((wgid % nig) % gsz); u.pn = (wgid % nig) / gsz; return true;
    }
    __device__ __forceinline__ void a_ready(const Unit&) const {}
    __device__ __forceinline__ void done(const Unit&) const {}
};


__device__ __forceinline__ unsigned cvt_pk_bf16(float lo, float hi) { unsigned r; asm volatile("v_cvt_pk_bf16_f32 %0, %1, %2" : "=v"(r) : "v"(lo), "v"(hi)); return r; }
struct EpiProjA {
    static constexpr bool PERM = true, AFTER_DRAIN = false;
    bf16_t* proj; float* dt; const float* rstd; int pitch, ntile_bf16, ntile_q; float qscale;
    __device__ __forceinline__ void operator()(const f32x4 (&acc)[2][2][4][2], const Unit& u, int wr, int wc, int fr, int fq) const {
        const int row0 = u.pm * BM + wr * 64 + fr;
        if (u.pn < ntile_bf16) {
            const int col0 = u.pn * BM + wc * 32 + 8 * fq;
#pragma unroll
            for (int ai = 0; ai < 2; ++ai)
#pragma unroll
                for (int m = 0; m < 4; ++m) { const int row = row0 + ai * HALF + m * 16; const float rs = rstd[row] * ((u.pn < ntile_q) ? qscale : 1.f); bf16_t* rowp = proj + (size_t)row * pitch + col0;
#pragma unroll
                    for (int bj = 0; bj < 2; ++bj) { const f32x4 v0 = acc[ai][bj][m][0] * rs, v1 = acc[ai][bj][m][1] * rs;
                        u32x4 w; w.x = cvt_pk_bf16(v0[0], v0[1]); w.y = cvt_pk_bf16(v0[2], v0[3]); w.z = cvt_pk_bf16(v1[0], v1[1]); w.w = cvt_pk_bf16(v1[2], v1[3]);
                        *(u32x4*)(rowp + bj * HALF) = w; } }
        } else if (wc == 0 && fq < 2) {
#pragma unroll
            for (int ai = 0; ai < 2; ++ai)
#pragma unroll
                for (int m = 0; m < 4; ++m) { const int row = row0 + ai * HALF + m * 16; const float rs = rstd[row]; float* dp = dt + (size_t)row * 16 + 8 * fq;
                    *(f32x4*)dp = acc[ai][0][m][0] * rs; *(f32x4*)(dp + 4) = acc[ai][0][m][1] * rs; }
        }
    }
};
struct EpiRes {
    static constexpr bool PERM = true, AFTER_DRAIN = false;
    const float* xin; float* xout; bf16_t* xb; float* ssq; int ldc;
    __device__ __forceinline__ void operator()(const f32x4 (&acc)[2][2][4][2], const Unit& u, int wr, int wc, int fr, int fq) const {
        const int row0 = u.pm * BM + wr * 64 + fr, col0 = u.pn * BM + wc * 32 + 8 * fq;
#pragma unroll
        for (int ai = 0; ai < 2; ++ai)
#pragma unroll
            for (int m = 0; m < 4; ++m) { const int row = row0 + ai * HALF + m * 16; const size_t off = (size_t)row * ldc + col0; float s = 0.f;
#pragma unroll
                for (int bj = 0; bj < 2; ++bj) { const f32x4 a = *(const f32x4*)(xin + off + bj * HALF), b = *(const f32x4*)(xin + off + bj * HALF + 4);
                    const f32x4 o0 = a + acc[ai][bj][m][0], o1 = b + acc[ai][bj][m][1];
                    *(f32x4*)(xout + off + bj * HALF) = o0; *(f32x4*)(xout + off + bj * HALF + 4) = o1;
                    s += (o0[0] * o0[0] + o0[1] * o0[1]) + (o0[2] * o0[2] + o0[3] * o0[3]) + (o1[0] * o1[0] + o1[1] * o1[1]) + (o1[2] * o1[2] + o1[3] * o1[3]);
                    if (xb) { u32x4 w; w.x = cvt_pk_bf16(o0[0], o0[1]); w.y = cvt_pk_bf16(o0[2], o0[3]); w.z = cvt_pk_bf16(o1[0], o1[1]); w.w = cvt_pk_bf16(o1[2], o1[3]); *(u32x4*)(xb + off + bj * HALF) = w; } }
                if (ssq) { s += __shfl_xor(s, 16); s += __shfl_xor(s, 32); if (fq == 0) ssq[(size_t)row * 16 + u.pn * 4 + wc] = s; }
                if (m & 1) asm volatile("" ::: "memory"); }
    }
};
struct EpiProjC {
    static constexpr bool PERM = true, AFTER_DRAIN = false;
    bf16_t* proj; const float* ssq; const float* bias; int pitch; float inv_n, eps; int ntile_q; float qscale;
    __device__ __forceinline__ void operator()(const f32x4 (&acc)[2][2][4][2], const Unit& u, int wr, int wc, int fr, int fq) const {
        const int row0 = u.pm * BM + wr * 64 + fr, col0 = u.pn * BM + wc * 32 + 8 * fq; const float qs = (u.pn < ntile_q) ? qscale : 1.f;
        f32x4 bv[2][2];
#pragma unroll
        for (int bj = 0; bj < 2; ++bj)
#pragma unroll
            for (int n = 0; n < 2; ++n) bv[bj][n] = *(const f32x4*)(bias + col0 + bj * HALF + 4 * n);
#pragma unroll
        for (int ai = 0; ai < 2; ++ai)
#pragma unroll
            for (int m = 0; m < 4; ++m) { const int row = row0 + ai * HALF + m * 16; const f32x4* sp = (const f32x4*)(ssq + (size_t)row * 16);
                const f32x4 p0 = sp[0], p1 = sp[1], p2 = sp[2], p3 = sp[3];
                const float ss = ((p0[0] + p0[1]) + (p0[2] + p0[3])) + ((p1[0] + p1[1]) + (p1[2] + p1[3])) + ((p2[0] + p2[1]) + (p2[2] + p2[3])) + ((p3[0] + p3[1]) + (p3[2] + p3[3]));
                const float rs = 1.0f / sqrtf(ss * inv_n + eps); bf16_t* rowp = proj + (size_t)row * pitch + col0;
#pragma unroll
                for (int bj = 0; bj < 2; ++bj) { const f32x4 v0 = (acc[ai][bj][m][0] * rs + bv[bj][0]) * qs, v1 = (acc[ai][bj][m][1] * rs + bv[bj][1]) * qs;
                    u32x4 w; w.x = cvt_pk_bf16(v0[0], v0[1]); w.y = cvt_pk_bf16(v0[2], v0[3]); w.z = cvt_pk_bf16(v1[0], v1[1]); w.w = cvt_pk_bf16(v1[2], v1[3]);
                    *(u32x4*)(rowp + bj * HALF) = w; }
                if (m & 1) asm volatile("" ::: "memory"); }
    }
};

template <class Epi, class Sched, bool ALIGN_EPI = false, bool SP2 = false>
__device__ __forceinline__ void gemm_phase(PG8_LAS unsigned char* lds, const Gemm g, const Sched& S, const Epi& E) {
    const int tid = threadIdx.x, wid = __builtin_amdgcn_readfirstlane(tid >> 6), lane = tid & 63, wr = wid >> 2, wc = wid & 3, fr = lane & 15, fq = lane >> 4;
    const int K = g.K, nt = K / BK;
    unsigned voffA[2], voffB[2];
#pragma unroll
    for (int i = 0; i < 2; ++i) { int R, C; stage_rc(tid * 16 + i * 8192, R, C); const int Rb = Epi::PERM ? ((R & ~31) + perm32(R & 31)) : R;
        voffA[i] = (unsigned)(R * K + C) * 2u; voffB[i] = (unsigned)(Rb * K + C) * 2u; }
    const size_t kstep = (size_t)(BK * 2);
    const size_t hstep = (size_t)HALF * K * 2;
    const size_t tstep = 2 * hstep;
    const unsigned ldsw = (unsigned)wid * 1024u;
    const int aoff = lds_byte(wr * 64 + fr, fq * 8), boff = lds_byte(wc * 32 + fr, fq * 8);
#define PG8_SA(b, h) (((b) * 2 + (h)) * HTB)
#define PG8_SB(b, h) ((4 + (b) * 2 + (h)) * HTB)
#define PG8_STAGE(bufoff, gbase, voff) do { _Pragma("unroll") for (int _i = 0; _i < 2; ++_i) \
        __builtin_amdgcn_global_load_lds((const unsigned*)((const char*)(gbase) + (voff)[_i]), (PG8_LAS unsigned*)(lds + (bufoff) + ldsw + _i * 8192), 16, 0, 0); } while (0)
#define PG8_LDA(dst, b, h) do { _Pragma("unroll") for (int m = 0; m < 4; ++m) _Pragma("unroll") for (int k = 0; k < 2; ++k) dst[m][k] = *(const PG8_LAS bf16x8*)(lds + PG8_SA(b, h) + aoff + m * 2048 + k * 1024); } while (0)
#define PG8_LDB(dst, b, h) do { _Pragma("unroll") for (int n = 0; n < 2; ++n) _Pragma("unroll") for (int k = 0; k < 2; ++k) dst[n][k] = *(const PG8_LAS bf16x8*)(lds + PG8_SB(b, h) + boff + n * 2048 + k * 1024); } while (0)
#define PG8_MMA(ai, bj, At, Bt) do { __builtin_amdgcn_s_setprio(1); _Pragma("unroll") for (int m = 0; m < 4; ++m) _Pragma("unroll") for (int n = 0; n < 2; ++n) _Pragma("unroll") for (int k = 0; k < 2; ++k) \
        acc[ai][bj][m][n] = __builtin_amdgcn_mfma_f32_16x16x32_bf16(Bt[n][k], At[m][k], acc[ai][bj][m][n], 0, 0, 0); __builtin_amdgcn_s_setprio(0); } while (0)
#define PG8_WAIT_V(n) asm volatile("s_waitcnt vmcnt(" #n ")" ::: "memory")
#define PG8_WAIT_L(n) asm volatile("s_waitcnt lgkmcnt(" #n ")" ::: "memory")
#define PG8_BAR __builtin_amdgcn_s_barrier()
#define PG8_SCHED __builtin_amdgcn_sched_barrier(0)
    Unit cur, nxt; int ui = 0;
    if (!S.next(0, cur)) return;
    f32x4 acc[2][2][4][2];
#pragma unroll
    for (int a = 0; a < 2; ++a)
#pragma unroll
        for (int b = 0; b < 2; ++b)
#pragma unroll
            for (int m = 0; m < 4; ++m)
#pragma unroll
                for (int n = 0; n < 2; ++n) acc[a][b][m][n] = (f32x4){0.f, 0.f, 0.f, 0.f};
    bf16x8 At[4][2], B0[2][2], B1[2][2];
    const char* cA = (const char*)g.A + (size_t)cur.pm * tstep; const char* cB = (const char*)g.Bt + (size_t)cur.pn * tstep;
    S.a_ready(cur);
    if constexpr (SP2) {
        PG8_STAGE(PG8_SB(0, 0), cB, voffB); PG8_STAGE(PG8_SB(0, 1), cB + hstep, voffB); PG8_STAGE(PG8_SA(0, 0), cA, voffA); PG8_STAGE(PG8_SA(0, 1), cA + hstep, voffA);
        if (wr == 1) PG8_BAR;
        PG8_WAIT_V(2); PG8_BAR;
        PG8_STAGE(PG8_SB(1, 0), cB + kstep, voffB); PG8_STAGE(PG8_SA(1, 0), cA + kstep, voffA); PG8_STAGE(PG8_SB(1, 1), cB + hstep + kstep, voffB);
        PG8_WAIT_V(6); PG8_BAR;
    } else {
        PG8_STAGE(PG8_SB(0, 0), cB, voffB); PG8_STAGE(PG8_SA(0, 0), cA, voffA); PG8_STAGE(PG8_SB(0, 1), cB + hstep, voffB); PG8_STAGE(PG8_SA(0, 1), cA + hstep, voffA);
        if (wr == 1) PG8_BAR;
        PG8_WAIT_V(4); PG8_BAR;
        PG8_STAGE(PG8_SB(1, 0), cB + kstep, voffB); PG8_STAGE(PG8_SA(1, 0), cA + kstep, voffA); PG8_STAGE(PG8_SB(1, 1), cB + hstep + kstep, voffB);
        PG8_WAIT_V(6); PG8_BAR;
    }
    for (;;) {
        const bool has_next = S.next(ui + 1, nxt);
        const char* nA = has_next ? (const char*)g.A + (size_t)nxt.pm * tstep : cA; const char* nB = has_next ? (const char*)g.Bt + (size_t)nxt.pn * tstep : cB;
        for (int t = 0; t < nt; t += 2) {
            const bool last = (t == nt - 2);
            const char* a1 = cA + (size_t)(t + 1) * kstep;
            const char* a2 = last ? nA : cA + (size_t)(t + 2) * kstep; const char* b2 = last ? nB : cB + (size_t)(t + 2) * kstep;
            const char* a3 = a2 + kstep; const char* b3 = b2 + kstep;
            if (last && has_next) S.a_ready(nxt);
            if constexpr (SP2) {
            PG8_LDB(B0, 0, 0); PG8_LDB(B1, 0, 1); PG8_SCHED; PG8_LDA(At, 0, 0); PG8_STAGE(PG8_SA(1, 1), a1 + hstep, voffA);
            PG8_WAIT_V(8); PG8_WAIT_L(0); PG8_BAR; PG8_MMA(0, 0, At, B0); PG8_MMA(0, 1, At, B1); PG8_BAR; PG8_SCHED;
            PG8_LDA(At, 0, 1); PG8_STAGE(PG8_SB(0, 0), b2, voffB); PG8_STAGE(PG8_SB(0, 1), b2 + hstep, voffB); PG8_STAGE(PG8_SA(0, 0), a2, voffA);
            PG8_WAIT_V(8); PG8_WAIT_L(0); PG8_BAR; PG8_MMA(1, 0, At, B0); PG8_MMA(1, 1, At, B1); PG8_BAR; PG8_SCHED;
            PG8_LDB(B0, 1, 0); PG8_LDB(B1, 1, 1); PG8_SCHED; PG8_LDA(At, 1, 0); PG8_STAGE(PG8_SA(0, 1), a2 + hstep, voffA);
            PG8_WAIT_V(8); PG8_WAIT_L(0); PG8_BAR; PG8_MMA(0, 0, At, B0); PG8_MMA(0, 1, At, B1); PG8_BAR; PG8_SCHED;
            PG8_LDA(At, 1, 1); PG8_STAGE(PG8_SB(1, 0), b3, voffB); PG8_STAGE(PG8_SB(1, 1), b3 + hstep, voffB); PG8_STAGE(PG8_SA(1, 0), a3, voffA);
            PG8_WAIT_V(8); PG8_WAIT_L(0); PG8_BAR; PG8_MMA(1, 0, At, B0); PG8_MMA(1, 1, At, B1); PG8_BAR; PG8_SCHED;
            } else {
            PG8_LDB(B0, 0, 0); PG8_SCHED; PG8_LDA(At, 0, 0); PG8_STAGE(PG8_SA(1, 1), a1 + hstep, voffA);
            PG8_WAIT_L(8); PG8_BAR; PG8_WAIT_L(0); PG8_MMA(0, 0, At, B0); PG8_BAR; PG8_SCHED;
            PG8_LDB(B1, 0, 1); PG8_STAGE(PG8_SB(0, 0), b2, voffB);
            PG8_BAR; PG8_WAIT_L(0); PG8_MMA(0, 1, At, B1); PG8_BAR;
            PG8_LDA(At, 0, 1); PG8_STAGE(PG8_SA(0, 0), a2, voffA);
            PG8_BAR; PG8_WAIT_L(0); PG8_MMA(1, 0, At, B0); PG8_BAR; PG8_SCHED;
            PG8_STAGE(PG8_SB(0, 1), b2 + hstep, voffB);
            PG8_WAIT_V(6); PG8_BAR; PG8_MMA(1, 1, At, B1); PG8_BAR;
            PG8_LDB(B0, 1, 0); PG8_SCHED; PG8_LDA(At, 1, 0); PG8_STAGE(PG8_SA(0, 1), a2 + hstep, voffA);
            PG8_WAIT_L(8); PG8_BAR; PG8_WAIT_L(0); PG8_MMA(0, 0, At, B0); PG8_BAR; PG8_SCHED;
            PG8_LDB(B1, 1, 1); PG8_STAGE(PG8_SB(1, 0), b3, voffB);
            PG8_BAR; PG8_WAIT_L(0); PG8_MMA(0, 1, At, B1); PG8_BAR;
            PG8_LDA(At, 1, 1); PG8_STAGE(PG8_SA(1, 0), a3, voffA);
            PG8_BAR; PG8_WAIT_L(0); PG8_MMA(1, 0, At, B0); PG8_BAR; PG8_SCHED;
            PG8_STAGE(PG8_SB(1, 1), b3 + hstep, voffB);
            PG8_WAIT_V(6); PG8_BAR; PG8_MMA(1, 1, At, B1); PG8_BAR;
            }
        }
        if constexpr (ALIGN_EPI) { if (wr == 0) PG8_BAR; }
        if constexpr (!Epi::AFTER_DRAIN) { E(acc, cur, wr, wc, fr, fq); S.done(cur); }
        if (!has_next) break;
#pragma unroll
        for (int a = 0; a < 2; ++a)
#pragma unroll
            for (int b = 0; b < 2; ++b)
#pragma unroll
                for (int m = 0; m < 4; ++m)
#pragma unroll
                    for (int n = 0; n < 2; ++n) acc[a][b][m][n] = (f32x4){0.f, 0.f, 0.f, 0.f};
        cur = nxt; cA = nA; cB = nB; ++ui;
        if constexpr (ALIGN_EPI) { if (wr == 1) PG8_BAR; }
    }
    PG8_WAIT_V(0);
    if constexpr (!ALIGN_EPI) { if (wr == 0) PG8_BAR; }
    PG8_BAR;
    if constexpr (Epi::AFTER_DRAIN) { E.fused(acc, cur, wr, wc, fr, fq, lds, wid, lane); S.done(cur); }
#undef PG8_SA
#undef PG8_SB
#undef PG8_STAGE
#undef PG8_LDA
#undef PG8_LDB
#undef PG8_MMA
#undef PG8_WAIT_V
#undef PG8_WAIT_L
#undef PG8_BAR
#undef PG8_SCHED
}
}

typedef short bf16x8 __attribute__((ext_vector_type(8)));
typedef short s16x4 __attribute__((ext_vector_type(4)));
typedef short v4i16_t __attribute__((ext_vector_type(4)));
typedef float f32x16 __attribute__((ext_vector_type(16)));
typedef LAS const char* lds_cptr;
__device__ __forceinline__ int crow(int r, int hi) { return (r & 3) + 8 * (r >> 2) + 4 * hi; }
__device__ __forceinline__ s16x4 vtr(lds_cptr p) { return __builtin_bit_cast(s16x4, __builtin_amdgcn_ds_read_tr16_b64_v4i16((LAS v4i16_t*)p)); }
__device__ __forceinline__ unsigned cvtpk(float lo, float hi) { unsigned r; asm volatile("v_cvt_pk_bf16_f32 %0, %1, %2" : "=v"(r) : "v"(lo), "v"(hi)); return r; }
__device__ __forceinline__ float swap32_max(float v) { auto rr = __builtin_amdgcn_permlane32_swap(__float_as_uint(v), __float_as_uint(v), false, false); return fmaxf(__uint_as_float(rr[0]), __uint_as_float(rr[1])); }
__device__ __forceinline__ float swap32_sum(float v) { auto rr = __builtin_amdgcn_permlane32_swap(__float_as_uint(v), __float_as_uint(v), false, false); return __uint_as_float(rr[0]) + __uint_as_float(rr[1]); }
__device__ __forceinline__ float silu_fast(float v) { return v * __builtin_amdgcn_rcpf(1.f + __builtin_amdgcn_exp2f(-LOG2E * v)); }
#define MFMA32(a, b, c) __builtin_amdgcn_mfma_f32_32x32x16_bf16((a), (b), (c), 0, 0, 0)

constexpr int DA_KOFF = 0, DA_VOFF = 16384, DA_BUF = 32768, DA_WS = 65536, DA_DIFF = 69632, DA_DPITCH = 132;
constexpr float QPRE = 0.125f * LOG2E;
__device__ __forceinline__ void fast_diffattn_unit(int b, int h, int qblk, LAS unsigned char* lds, const bf16_t* proj, float lam, const float* subln, bf16_t* Y, int ypitch) {
    const int tid = threadIdx.x, lane = tid & 63, wave = __builtin_amdgcn_readfirstlane(tid >> 6), r32 = lane & 31, hh = lane >> 5, mp = wave >> 2, qs = wave & 3;
    const int q0 = qblk * 128 + qs * 32;
    const size_t rowbase = (size_t)b * SEQ;
    bf16x8 qf[4];
#pragma unroll
    for (int ds = 0; ds < 4; ++ds) qf[ds] = *(const bf16x8*)(proj + (rowbase + q0 + r32) * PROJ_P + CQ + h * 128 + mp * 64 + ds * 16 + hh * 8);
    const float slope2 = exp2f(-(float)(h + 1)) * LOG2E;
    f32x16 o[4];
#pragma unroll
    for (int d = 0; d < 4; ++d)
#pragma unroll
        for (int r = 0; r < 16; ++r) o[d][r] = 0.f;
    float m = 0.f, l = 0.f;
    LAS float* wsf = (LAS float*)(lds + DA_WS) + wave * 64;
    const int T = 2 * (qblk + 1);
    const int srow = 8 * wave + (lane >> 3), c8 = lane & 7;
    const bf16_t* ksrc = proj + (rowbase + srow) * PROJ_P + CK + h * 128 + c8 * 8;
    const bf16_t* vsrc = proj + (rowbase + srow) * PROJ_P + CV + h * 128 + c8 * 8;
    const int kdst = DA_KOFF + srow * 256 + ((c8 ^ (srow & 15)) * 16);
    const int vdst = DA_VOFF + ((c8 >> 2) * 4 + (srow >> 4)) * 1024 + (srow & 15) * 64 + (c8 & 3) * 16;
    u32x4 kr[2], vr[2];
#define DA_LOAD(t) do { const size_t to_ = (size_t)(t) * 64 * PROJ_P; kr[0] = *(const u32x4*)(ksrc + to_); kr[1] = *(const u32x4*)(ksrc + to_ + 64); vr[0] = *(const u32x4*)(vsrc + to_); vr[1] = *(const u32x4*)(vsrc + to_ + 64); } while (0)
#define DA_WRITE(bo) do { *(LAS u32x4*)(lds + (bo) + kdst) = kr[0]; *(LAS u32x4*)(lds + (bo) + (kdst ^ 128)) = kr[1]; *(LAS u32x4*)(lds + (bo) + vdst) = vr[0]; *(LAS u32x4*)(lds + (bo) + vdst + 8192) = vr[1]; } while (0)
    DA_LOAD(T - 1); DA_WRITE(0);
    __syncthreads();
    const int kf0 = DA_KOFF + r32 * 256 + (((8 * mp + hh) ^ (r32 & 15)) * 16);
    const int vfo = DA_VOFF + ((lane >> 4) & 1) * 32 + (lane & 3) * 8 + (4 * hh + ((lane & 15) >> 2)) * 64;
    for (int it = 0; it < T; ++it) {
        const int t = T - 1 - it, bo = (it & 1) * DA_BUF;
        if (it + 1 < T) DA_LOAD(t - 1);
        if (64 * t <= q0 + 31) {
            const float tbm = slope2 * (float)(64 * t + 4 * hh - q0) - m;
            f32x16 s0, s1;
#pragma unroll
            for (int r = 0; r < 16; ++r) { s0[r] = slope2 * (float)((r & 3) + 8 * (r >> 2)) + tbm; s1[r] = slope2 * (float)((r & 3) + 8 * (r >> 2) + 32) + tbm; }
#pragma unroll
            for (int ds = 0; ds < 4; ++ds) {
                lds_cptr ka = (lds_cptr)(lds + bo + (kf0 ^ (32 * ds)));
                const bf16x8 a0 = *(const LAS bf16x8*)(ka), a1 = *(const LAS bf16x8*)(ka + 8192);
                s0 = MFMA32(a0, qf[ds], s0); s1 = MFMA32(a1, qf[ds], s1);
            }
            if (64 * t + 63 > q0) {
                const int qrel = q0 + r32 - 64 * t - 4 * hh;
#pragma unroll
                for (int r = 0; r < 16; ++r) { const int kv = (r & 3) + 8 * (r >> 2); if (kv > qrel) s0[r] = -INFINITY; if (kv + 32 > qrel) s1[r] = -INFINITY; }
            }
            float mx = fmaxf(s0[0], s1[0]);
#pragma unroll
            for (int r = 1; r < 16; ++r) mx = fmaxf(mx, fmaxf(s0[r], s1[r]));
            mx = swap32_max(mx);
            if (!__all(mx < -150.f)) {
                if (__any(mx > 8.f)) {
                    const float dl = fmaxf(mx, 0.f), al = __builtin_amdgcn_exp2f(-dl);
                    m += dl; l *= al;
                    if (hh == 0) wsf[r32] = al;
#pragma unroll
                    for (int r = 0; r < 16; ++r) { const float ar = wsf[crow(r, hh)]; s0[r] -= dl; s1[r] -= dl;
#pragma unroll
                        for (int d = 0; d < 4; ++d) o[d][r] *= ar; }
                }
                float ps = 0.f;
#pragma unroll
                for (int r = 0; r < 16; ++r) { s0[r] = __builtin_amdgcn_exp2f(s0[r]); s1[r] = __builtin_amdgcn_exp2f(s1[r]); ps += s0[r] + s1[r]; }
                l += ps;
                u32x4 pw[4];
#pragma unroll
                for (int k = 0; k < 2; ++k)
#pragma unroll
                    for (int j = 0; j < 4; ++j) { pw[k][j] = cvtpk(s0[8 * k + 2 * j], s0[8 * k + 2 * j + 1]); pw[2 + k][j] = cvtpk(s1[8 * k + 2 * j], s1[8 * k + 2 * j + 1]); }
                lds_cptr vb = (lds_cptr)(lds + bo + vfo);
#pragma unroll
                for (int d = 0; d < 4; ++d)
#pragma unroll
                    for (int ks = 0; ks < 4; ++ks) {
                        const s16x4 lo = vtr(vb + d * 4096 + ks * 1024), hi = vtr(vb + d * 4096 + ks * 1024 + 512);
                        const bf16x8 vf = (bf16x8){lo[0], lo[1], lo[2], lo[3], hi[0], hi[1], hi[2], hi[3]};
                        o[d] = MFMA32(__builtin_bit_cast(bf16x8, pw[ks]), vf, o[d]);
                    }
            }
        }
        if (it + 1 < T) DA_WRITE(((it + 1) & 1) * DA_BUF);
        __syncthreads();
    }
#undef DA_LOAD
#undef DA_WRITE
    l = swap32_sum(l);
    if (hh == 0) wsf[r32] = 1.f / l;
    float inv[16];
#pragma unroll
    for (int r = 0; r < 16; ++r) inv[r] = wsf[crow(r, hh)];
    LAS float* exch = (LAS float*)lds + qs * 4096;
    if (mp == 1) {
#pragma unroll
        for (int d = 0; d < 4; ++d)
#pragma unroll
            for (int r = 0; r < 16; ++r) exch[(d * 16 + r) * 64 + lane] = o[d][r] * inv[r] * lam;
    }
    __syncthreads();
    LAS float* dimg = (LAS float*)(lds + DA_DIFF);
    if (mp == 0) {
#pragma unroll
        for (int d = 0; d < 4; ++d)
#pragma unroll
            for (int r = 0; r < 16; ++r) dimg[(qs * 32 + crow(r, hh)) * DA_DPITCH + d * 32 + r32] = o[d][r] * inv[r] - exch[(d * 16 + r) * 64 + lane];
    }
    __syncthreads();
    {
        const int row = tid >> 2, qt = tid & 3; const size_t grow = rowbase + qblk * 128 + row;
        f32x4 dv[8]; float ss = 0.f;
#pragma unroll
        for (int i = 0; i < 8; ++i) { dv[i] = *(const LAS f32x4*)(dimg + row * DA_DPITCH + qt * 32 + 4 * i); ss += (dv[i][0] * dv[i][0] + dv[i][1] * dv[i][1]) + (dv[i][2] * dv[i][2] + dv[i][3] * dv[i][3]); }
        ss += __shfl_xor(ss, 1); ss += __shfl_xor(ss, 2);
        const float rn = (1.f - LAMBDA_INIT) / sqrtf(ss * (1.f / 128.f) + EPS);
        const u32x4* gp = (const u32x4*)(proj + grow * PROJ_P + CGA + h * 128 + qt * 32); u32x4* yp = (u32x4*)(Y + grow * ypitch + h * 128 + qt * 32);
        const f32x4* wp = (const f32x4*)(subln + qt * 32);
#pragma unroll
        for (int i = 0; i < 4; ++i) { const u32x4 g = gp[i]; const f32x4 w0 = wp[2 * i], w1 = wp[2 * i + 1], d0 = dv[2 * i], d1 = dv[2 * i + 1]; u32x4 y;
            y.x = cvtpk(d0[0] * rn * w0[0] * silu_fast(bf2f(g.x & 0xffffu)), d0[1] * rn * w0[1] * silu_fast(bf2f(g.x >> 16)));
            y.y = cvtpk(d0[2] * rn * w0[2] * silu_fast(bf2f(g.y & 0xffffu)), d0[3] * rn * w0[3] * silu_fast(bf2f(g.y >> 16)));
            y.z = cvtpk(d1[0] * rn * w1[0] * silu_fast(bf2f(g.z & 0xffffu)), d1[1] * rn * w1[1] * silu_fast(bf2f(g.z >> 16)));
            y.w = cvtpk(d1[2] * rn * w1[2] * silu_fast(bf2f(g.w & 0xffffu)), d1[3] * rn * w1[3] * silu_fast(bf2f(g.w >> 16)));
            yp[i] = y; }
    }
    __syncthreads();
}

constexpr int SW_TILE = 16384, SW_BUF = 3 * SW_TILE, SW_WS = 2 * SW_BUF, SW_STG = SW_WS + 2048, SW_SPITCH = 36;
__device__ __forceinline__ void fast_swa_group(int ug, LAS unsigned char* lds, const bf16_t* projc, const float* sinks, bf16_t* OGb, int opitch) {
    const int tid = threadIdx.x, lane = tid & 63, wave = __builtin_amdgcn_readfirstlane(tid >> 6), r32 = lane & 31, hh = lane >> 5;
    LAS float* wsf = (LAS float*)(lds + SW_WS) + wave * 64;
    LAS float* stg = (LAS float*)(lds + SW_STG) + wave * (32 * SW_SPITCH);
    const int srow = 8 * wave + (lane >> 3), c8 = lane & 7;
    const int kdst = srow * 128 + ((c8 ^ ((srow >> 1) & 7)) * 16), vdst = 8192 + ((c8 >> 2) * 4 + (srow >> 4)) * 1024 + (srow & 15) * 64 + (c8 & 3) * 16;
    const int kf0 = r32 * 128 + ((hh ^ ((r32 >> 1) & 7)) * 16);
    const int vfo = 8192 + ((lane >> 4) & 1) * 32 + (lane & 3) * 8 + (4 * hh + ((lane & 15) >> 2)) * 64;
    const int grow_l = lane >> 1, ghf = lane & 1;
    u32x4 kr[3], vr[3]; bf16x8 qn[4];
#define SW_DECODE(u, b_, kvh_, q0_, thi_, nt_) const int b_ = (u) >> 7, kvh_ = ((u) >> 6) & 1, q0_ = ((u) & 63) * 32, thi_ = (q0_ + 31) >> 6, nt_ = thi_ - ((q0_ >= 127) ? ((q0_ - 127) >> 6) : 0) + 1
#define SW_LOAD(u) do { SW_DECODE(u, b_, kvh_, q0_, thi_, nt_); const int head_ = kvh_ * 8 + wave; \
        const bf16_t* ks_ = projc + ((size_t)b_ * SEQ + srow) * ODD_IN + OK_ + kvh_ * 64 + c8 * 8; \
        _Pragma("unroll") for (int s_ = 0; s_ < 3; ++s_) if (s_ < nt_) { const size_t to_ = (size_t)(thi_ - s_) * 64 * ODD_IN; kr[s_] = *(const u32x4*)(ks_ + to_); vr[s_] = *(const u32x4*)(ks_ + to_ + (OV - OK_)); } \
        const bf16_t* qp_ = projc + ((size_t)b_ * SEQ + q0_ + r32) * ODD_IN + OQ + head_ * 64 + hh * 8; \
        _Pragma("unroll") for (int ds = 0; ds < 4; ++ds) qn[ds] = *(const bf16x8*)(qp_ + ds * 16); } while (0)
#define SW_WRITE(u, bo) do { SW_DECODE(u, b_, kvh_, q0_, thi_, nt_); (void)b_; (void)kvh_; (void)q0_; \
        _Pragma("unroll") for (int s_ = 0; s_ < 3; ++s_) if (s_ < nt_) { *(LAS u32x4*)(lds + (bo) + s_ * SW_TILE + kdst) = kr[s_]; *(LAS u32x4*)(lds + (bo) + s_ * SW_TILE + vdst) = vr[s_]; } } while (0)
    const int u0 = ug * 8;
    SW_LOAD(u0); SW_WRITE(u0, 0);
    __syncthreads();
    for (int i = 0; i < 8; ++i) {
        const int u = u0 + i, bo = (i & 1) * SW_BUF;
        bf16x8 qf[4]; u32x4 gc[4];
#pragma unroll
        for (int ds = 0; ds < 4; ++ds) qf[ds] = qn[ds];
        { SW_DECODE(u, b_, kvh_, q0_, thi_, nt_); (void)thi_; (void)nt_;
          const bf16_t* gp_ = projc + ((size_t)b_ * SEQ + q0_ + grow_l) * ODD_IN + OG_ + (kvh_ * 8 + wave) * 64 + ghf * 16;
#pragma unroll
          for (int d = 0; d < 2; ++d) { gc[2 * d] = *(const u32x4*)(gp_ + d * 32); gc[2 * d + 1] = *(const u32x4*)(gp_ + d * 32 + 8); } }
        if (i + 1 < 8) SW_LOAD(u + 1);
        {
            SW_DECODE(u, b, kvh, q0, thi, nt);
            const int head = kvh * 8 + wave; const size_t rowbase = (size_t)b * SEQ;
            const float slope2 = exp2f(-0.5f * (float)(head + 1)) * LOG2E;
            float m = sinks[head] * LOG2E + slope2 * (float)r32, l = (hh == 0) ? 1.f : 0.f;
            f32x16 o[2];
#pragma unroll
            for (int d = 0; d < 2; ++d)
#pragma unroll
                for (int r = 0; r < 16; ++r) o[d][r] = 0.f;
            for (int s = 0; s < nt; ++s) {
                const int t = thi - s;
                const float tbm = slope2 * (float)(64 * t + 4 * hh - q0) - m;
                f32x16 s0, s1;
#pragma unroll
                for (int r = 0; r < 16; ++r) { s0[r] = slope2 * (float)((r & 3) + 8 * (r >> 2)) + tbm; s1[r] = slope2 * (float)((r & 3) + 8 * (r >> 2) + 32) + tbm; }
#pragma unroll
                for (int ds = 0; ds < 4; ++ds) {
                    lds_cptr ka = (lds_cptr)(lds + bo + s * SW_TILE + (kf0 ^ (32 * ds)));
                    const bf16x8 a0 = *(const LAS bf16x8*)(ka), a1 = *(const LAS bf16x8*)(ka + 4096);
                    s0 = MFMA32(a0, qf[ds], s0); s1 = MFMA32(a1, qf[ds], s1);
                }
                const int qrel = q0 + r32 - 64 * t - 4 * hh;
                if (64 * t + 63 > q0 || 64 * t < q0 + 31 - 127) {
#pragma unroll
                    for (int r = 0; r < 16; ++r) { const int kv = (r & 3) + 8 * (r >> 2);
                        if (kv > qrel || kv < qrel - 127) s0[r] = -INFINITY;
                        if (kv + 32 > qrel || kv + 32 < qrel - 127) s1[r] = -INFINITY; }
                }
                float mx = fmaxf(s0[0], s1[0]);
#pragma unroll
                for (int r = 1; r < 16; ++r) mx = fmaxf(mx, fmaxf(s0[r], s1[r]));
                mx = swap32_max(mx);
                if (__any(mx > 8.f)) {
                    const float dl = fmaxf(mx, 0.f), al = __builtin_amdgcn_exp2f(-dl);
                    m += dl; l *= al;
                    if (hh == 0) wsf[r32] = al;
#pragma unroll
                    for (int r = 0; r < 16; ++r) { const float ar = wsf[crow(r, hh)]; s0[r] -= dl; s1[r] -= dl; o[0][r] *= ar; o[1][r] *= ar; }
                }
                float ps = 0.f;
#pragma unroll
                for (int r = 0; r < 16; ++r) { s0[r] = __builtin_amdgcn_exp2f(s0[r]); s1[r] = __builtin_amdgcn_exp2f(s1[r]); ps += s0[r] + s1[r]; }
                l += ps;
                u32x4 pw[4];
#pragma unroll
                for (int k = 0; k < 2; ++k)
#pragma unroll
                    for (int j = 0; j < 4; ++j) { pw[k][j] = cvtpk(s0[8 * k + 2 * j], s0[8 * k + 2 * j + 1]); pw[2 + k][j] = cvtpk(s1[8 * k + 2 * j], s1[8 * k + 2 * j + 1]); }
                lds_cptr vb = (lds_cptr)(lds + bo + s * SW_TILE + vfo);
#pragma unroll
                for (int d = 0; d < 2; ++d)
#pragma unroll
                    for (int ks = 0; ks < 4; ++ks) {
                        const s16x4 lo = vtr(vb + d * 4096 + ks * 1024), hi = vtr(vb + d * 4096 + ks * 1024 + 512);
                        const bf16x8 vf = (bf16x8){lo[0], lo[1], lo[2], lo[3], hi[0], hi[1], hi[2], hi[3]};
                        o[d] = MFMA32(__builtin_bit_cast(bf16x8, pw[ks]), vf, o[d]);
                    }
            }
            if (i + 1 < 8) SW_WRITE(u + 1, ((i + 1) & 1) * SW_BUF);
            l = swap32_sum(l);
            if (hh == 0) wsf[r32] = 1.f / l;
            float inv[16];
#pragma unroll
            for (int r = 0; r < 16; ++r) inv[r] = wsf[crow(r, hh)];
            const size_t grow = rowbase + q0 + grow_l;
#pragma unroll
            for (int d = 0; d < 2; ++d) {
#pragma unroll
                for (int r = 0; r < 16; ++r) stg[crow(r, hh) * SW_SPITCH + r32] = o[d][r] * inv[r];
                u32x4* op = (u32x4*)(OGb + grow * opitch + head * 64 + d * 32 + ghf * 16);
#pragma unroll
                for (int i2 = 0; i2 < 2; ++i2) { const u32x4 g = gc[2 * d + i2]; const f32x4 a0 = *(const LAS f32x4*)(stg + grow_l * SW_SPITCH + ghf * 16 + 8 * i2), a1 = *(const LAS f32x4*)(stg + grow_l * SW_SPITCH + ghf * 16 + 8 * i2 + 4); u32x4 y;
                    y.x = cvtpk(a0[0] * silu_fast(bf2f(g.x & 0xffffu)), a0[1] * silu_fast(bf2f(g.x >> 16))); y.y = cvtpk(a0[2] * silu_fast(bf2f(g.y & 0xffffu)), a0[3] * silu_fast(bf2f(g.y >> 16)));
                    y.z = cvtpk(a1[0] * silu_fast(bf2f(g.z & 0xffffu)), a1[1] * silu_fast(bf2f(g.z >> 16))); y.w = cvtpk(a1[2] * silu_fast(bf2f(g.w & 0xffffu)), a1[3] * silu_fast(bf2f(g.w >> 16)));
                    op[i2] = y; }
            }
        }
        __syncthreads();
    }
#undef SW_DECODE
#undef SW_LOAD
#undef SW_WRITE
}

constexpr int SS_BM = 0, SS_CM = 32768, SS_XDT = 65536, SS_XW = 81920, SS_H = 98304, SS_ZT = 114688, SS_ZP = 144, SS_F = 133120;
__device__ __forceinline__ int rowoff_a(int row) { return 2048 * (row >> 3) + 64 * (row & 7); }
__device__ __forceinline__ int off_a(int row, int ch) { return rowoff_a(row) + 512 * (ch >> 2) + 16 * ((ch & 3) ^ ((row >> 2) & 3)); }
__device__ __forceinline__ void fast_ssd_unit(int b, int hd, LAS unsigned char* lds, const bf16_t* proj, const float* dtraw, const float* conv_w, const float* conv_b, const float* dt_bias, const float* a_log,
                                              const float* d_skip, bf16_t* Y, int ypitch, int ycol0, float* ssq, const bf16_t* bcact) {
    const int tid = threadIdx.x, lane = tid & 63, wave = __builtin_amdgcn_readfirstlane(tid >> 6), r32 = lane & 31, hh = lane >> 5, lb = wave & 3, pb = wave >> 2, g = hd >> 3;
    const size_t rowbase = (size_t)b * SEQ;
    LAS float* fdt = (LAS float*)(lds + SS_F); LAS float* fcs = fdt + 128; LAS float* fecs = fdt + 256;
    LAS float* wl = (LAS float*)(lds + SS_F + 2048);
    const float A2 = -__expf(a_log[hd]) * LOG2E, dtb = dt_bias[hd], Dk = d_skip[hd];
    for (int i = tid; i < 320; i += 512) { const int j = i >> 6, ch = hd * 64 + (i & 63); wl[i] = (j < 4) ? conv_w[j * 1536 + ch] : conv_b[ch]; }
    f32x16 Hacc;
#pragma unroll
    for (int r = 0; r < 16; ++r) Hacc[r] = 0.f;
    const __amdgpu_buffer_rsrc_t prs = __builtin_amdgcn_make_buffer_rsrc((void*)(proj + rowbase * PROJ_P - 3 * PROJ_P), (short)0, (int)((SEQ + 3) * PROJ_P * 2), 0x00020000);
    const __amdgpu_buffer_rsrc_t brs = __builtin_amdgcn_make_buffer_rsrc((void*)(bcact + rowbase * 512), (short)0, (int)(SEQ * 512 * 2), 0x00020000);
#define SS_ROLES(t_) const int half = (t_) >> 8, cc1 = (t_) & 15, run = ((t_) & 255) >> 4, cc2 = (t_) & 7, rr2 = (t_) >> 3; \
    const int toff1 = 2 * (8 * run * 512 + half * 256 + g * 128 + cc1 * 8), toff2 = 2 * (2 * rr2 * PROJ_P + CXS + hd * 64 + cc2 * 8), toffz = 2 * (rr2 * PROJ_P + CZ + hd * 64 + cc2 * 8); \
    (void)half; (void)cc1; (void)run; (void)cc2; (void)rr2; (void)toff1; (void)toff2; (void)toffz
    u32x4 raw1[8], raw2[5], zr[2]; float dr0 = 0.f, dr1 = 0.f;
    u32x4 oy0, oy1; float oss = 0.f;
#define SS_STORE_OUT(cp) do { const int row_ = tid >> 2, qt_ = tid & 3; const size_t gr_ = rowbase + (size_t)(cp) * 128 + row_; \
        u32x4* yp_ = (u32x4*)(Y + gr_ * ypitch + ycol0 + hd * 64 + qt_ * 16); yp_[0] = oy0; yp_[1] = oy1; if (qt_ == 0) ssq[gr_ * 16 + hd] = oss; } while (0)
#define SS_BLD(voff, row) __builtin_bit_cast(u32x4, __builtin_amdgcn_raw_buffer_load_b128(prs, (voff), (int)(((row) + 3) * (PROJ_P * 2)), 0))
#define SS_PREFETCH1(cn) do { \
        _Pragma("unroll") for (int i = 0; i < 8; ++i) raw1[i] = __builtin_bit_cast(u32x4, __builtin_amdgcn_raw_buffer_load_b128(brs, toff1, (int)(((cn) * 128 + i) * 1024), 0)); } while (0)
#define SS_PREFETCHD(cn) do { if (wave == 0) { dr0 = dtraw[(rowbase + (size_t)(cn) * 128 + 2 * lane) * 16 + hd]; dr1 = dtraw[(rowbase + (size_t)(cn) * 128 + 2 * lane + 1) * 16 + hd]; } } while (0)
#define SS_PREFETCH2(cn) do { \
        _Pragma("unroll") for (int i = 0; i < 5; ++i) { const bool ok = ((cn) > 0) || (2 * rr2 + i >= 3); raw2[i] = ok ? SS_BLD(toff2, (cn) * 128 + i - 3) : (u32x4){0u, 0u, 0u, 0u}; } \
        zr[0] = SS_BLD(toffz, (cn) * 128); zr[1] = SS_BLD(toffz, (cn) * 128 + 64); } while (0)
#define SS_PART0() do { if (wave == 0) { const float r0 = dr0 + dtb, r1 = dr1 + dtb; \
        const float d0 = (r0 > 20.f) ? r0 : log1pf(__expf(r0)), d1 = (r1 > 20.f) ? r1 : log1pf(__expf(r1)); \
        const float a0 = d0 * A2, a1 = d1 * A2; float s = a0 + a1; \
        _Pragma("unroll") for (int o = 1; o < 64; o <<= 1) { const float t = __shfl_up(s, o); if (lane >= o) s += t; } \
        const float c1 = s, c0 = s - a1; \
        fdt[2 * lane] = d0; fdt[2 * lane + 1] = d1; fcs[2 * lane] = c0; fcs[2 * lane + 1] = c1; fecs[2 * lane] = __builtin_amdgcn_exp2f(c0); fecs[2 * lane + 1] = __builtin_amdgcn_exp2f(c1); } } while (0)
    SS_PREFETCHD(0); SS_PART0();
    { SS_ROLES(tid); SS_PREFETCH1(0); SS_PREFETCH2(0); }
    __syncthreads();
    for (int c = 0; c < 16; ++c) {
        const size_t crow0 = rowbase + (size_t)c * 128;
        {
        if (c > 0) SS_STORE_OUT(c - 1);
        int tS = threadIdx.x; asm volatile("" : "+v"(tS));
        SS_ROLES(tS);
        {
            LAS unsigned char* img = lds + (half ? SS_CM : SS_BM) + 2048 * run + 512 * (cc1 >> 2);
#pragma unroll
            for (int r = 0; r < 8; ++r) *(LAS u32x4*)(img + 64 * r + 16 * ((cc1 & 3) ^ ((2 * run + (r >> 2)) & 3))) = raw1[r];
        }
        __builtin_amdgcn_sched_barrier(0);
        *(LAS u32x4*)(lds + SS_ZT + rr2 * SS_ZP + cc2 * 16) = zr[0]; *(LAS u32x4*)(lds + SS_ZT + (rr2 + 64) * SS_ZP + cc2 * 16) = zr[1];
        {
            f32x4 w[4][2], bs[2];
            LAS const float* wp = wl + cc2 * 8;
#pragma unroll
            for (int j = 0; j < 4; ++j) { w[j][0] = *(const LAS f32x4*)(wp + j * 64); w[j][1] = *(const LAS f32x4*)(wp + j * 64 + 4); }
            bs[0] = *(const LAS f32x4*)(wp + 4 * 64); bs[1] = *(const LAS f32x4*)(wp + 4 * 64 + 4);
            const float cl = fcs[127];
#pragma unroll
            for (int r = 0; r < 2; ++r) {
                const int row = 2 * rr2 + r; const float dtv = fdt[row], dec = __builtin_amdgcn_exp2f(cl - fcs[row]);
                float v[8];
#pragma unroll
                for (int e = 0; e < 8; ++e) v[e] = bs[e >> 2][e & 3];
#pragma unroll
                for (int j = 0; j < 4; ++j)
#pragma unroll
                    for (int e = 0; e < 4; ++e) { const unsigned wd = raw2[r + j][e]; v[2 * e] += w[j][(2 * e) >> 2][(2 * e) & 3] * bf2f(wd & 0xffffu); v[2 * e + 1] += w[j][(2 * e + 1) >> 2][(2 * e + 1) & 3] * bf2f(wd >> 16); }
                u32x4 o1, o2;
#pragma unroll
                for (int e = 0; e < 4; ++e) { const unsigned xb = cvtpk(silu_fast(v[2 * e]), silu_fast(v[2 * e + 1])); const float x0 = bf2f(xb & 0xffffu) * dtv, x1 = bf2f(xb >> 16) * dtv; o1[e] = cvtpk(x0, x1); o2[e] = cvtpk(x0 * dec, x1 * dec); }
                const int po = ((cc2 >> 2) * 8 + (row >> 4)) * 1024 + (row & 15) * 64 + (cc2 & 3) * 16;
                *(LAS u32x4*)(lds + SS_XDT + po) = o1; *(LAS u32x4*)(lds + SS_XW + po) = o2;
            }
        }
        __builtin_amdgcn_sched_barrier(0);
        if (c < 15) { SS_PREFETCH1(c + 1); SS_PREFETCH2(c + 1); SS_PREFETCHD(c + 1); }
        }
        __syncthreads();
        {
            int tC = threadIdx.x; asm volatile("" : "+v"(tC));
            const int lane = tC & 63, r32 = lane & 31, hh = lane >> 5, blk = (lane >> 4) & 1, q4 = (lane & 15) >> 2, p4 = lane & 3;
            const int xr = (r32 >> 2) & 3, rr0 = rowoff_a(r32) + 16 * (hh ^ xr), rr1 = rowoff_a(r32) + 16 * ((hh ^ xr) ^ 2);
            const int tb0 = 2048 * hh + 512 * lb + 64 * q4 + 16 * ((2 * blk + (p4 >> 1)) ^ ((2 * hh) & 3)) + 8 * (p4 & 1);
            const int tb1 = 2048 * hh + 512 * lb + 64 * (4 + q4) + 16 * ((2 * blk + (p4 >> 1)) ^ ((2 * hh + 1) & 3)) + 8 * (p4 & 1);
            const int vfo = blk * 32 + p4 * 8 + (4 * hh + q4) * 64;
            const int vfn = blk * 32 + p4 * 8 + (8 * hh + q4) * 64;
            const float csl = fcs[32 * lb + r32];
            f32x16 yacc;
#pragma unroll
            for (int r = 0; r < 16; ++r) yacc[r] = 0.f;
            lds_cptr cfr0 = (lds_cptr)(lds + SS_CM + 8192 * lb + rr0), cfr1 = (lds_cptr)(lds + SS_CM + 8192 * lb + rr1);
            for (int sb = 0; sb <= lb; ++sb) {
                f32x16 X;
#pragma unroll
                for (int r = 0; r < 16; ++r) X[r] = 0.f;
                lds_cptr bfr0 = (lds_cptr)(lds + SS_BM + 8192 * sb + rr0), bfr1 = (lds_cptr)(lds + SS_BM + 8192 * sb + rr1);
#pragma unroll
                for (int ks = 0; ks < 8; ++ks) {
                    const bf16x8 af = *(const LAS bf16x8*)(((ks & 1) ? bfr1 : bfr0) + 512 * (ks >> 1)), bq = *(const LAS bf16x8*)(((ks & 1) ? cfr1 : cfr0) + 512 * (ks >> 1));
                    X = MFMA32(af, bq, X);
                }
                LAS const float* csb = fcs + 32 * sb + 4 * hh;
#pragma unroll
                for (int r = 0; r < 16; ++r) { const int si = (r & 3) + 8 * (r >> 2); const float cv = csb[si];
                    float e = __builtin_amdgcn_exp2f(fminf(csl - cv, 0.f)); e = ((sb == lb) && (si + 4 * hh > r32)) ? 0.f : e; X[r] *= e; }
#pragma unroll
                for (int k2 = 0; k2 < 2; ++k2) {
                    u32x4 pw;
#pragma unroll
                    for (int j = 0; j < 4; ++j) pw[j] = cvtpk(X[8 * k2 + 2 * j], X[8 * k2 + 2 * j + 1]);
                    lds_cptr vb = (lds_cptr)(lds + SS_XDT + (pb * 8 + 2 * sb + k2) * 1024 + vfo);
                    const s16x4 lo = vtr(vb), hi = vtr(vb + 512);
                    const bf16x8 vf = (bf16x8){lo[0], lo[1], lo[2], lo[3], hi[0], hi[1], hi[2], hi[3]};
                    yacc = MFMA32(__builtin_bit_cast(bf16x8, pw), vf, yacc);
                }
            }
            if (c > 0) {
                f32x16 yo;
#pragma unroll
                for (int r = 0; r < 16; ++r) yo[r] = 0.f;
                lds_cptr hfr0 = (lds_cptr)(lds + SS_H + 8192 * pb + rr0), hfr1 = (lds_cptr)(lds + SS_H + 8192 * pb + rr1);
#pragma unroll
                for (int ks = 0; ks < 8; ++ks) {
                    const bf16x8 af = *(const LAS bf16x8*)(((ks & 1) ? cfr1 : cfr0) + 512 * (ks >> 1)), bq = *(const LAS bf16x8*)(((ks & 1) ? hfr1 : hfr0) + 512 * (ks >> 1));
                    yo = MFMA32(af, bq, yo);
                }
                LAS const float* eb = fecs + 32 * lb + 4 * hh;
#pragma unroll
                for (int r = 0; r < 16; ++r) yacc[r] += eb[(r & 3) + 8 * (r >> 2)] * yo[r];
            }
            {
                LAS const float* db_ = fdt + 32 * lb + 4 * hh;
                LAS unsigned char* zt = lds + SS_ZT + (32 * lb + 4 * hh) * SS_ZP + (32 * pb + r32) * 2;
                lds_cptr xe = (lds_cptr)(lds + SS_XDT + (pb * 8 + 2 * lb) * 1024 + (4 * hh) * 64 + r32 * 2);
#pragma unroll
                for (int r = 0; r < 16; ++r) {
                    const int si = (r & 3) + 8 * (r >> 2);
                    const float xdtv = bf2f(*(const LAS unsigned short*)(xe + (si >> 4) * 1024 + (si & 15) * 64));
                    const float y = yacc[r] + (Dk * __builtin_amdgcn_rcpf(db_[si])) * xdtv;
                    const float z = bf2f(*(const LAS unsigned short*)(zt + si * SS_ZP));
                    *(LAS unsigned short*)(zt + si * SS_ZP) = (unsigned short)f2bf(y * silu_fast(z));
                }
            }
            if (c < 15) {
                const float dl = fecs[127];
#pragma unroll
                for (int r = 0; r < 16; ++r) Hacc[r] *= dl;
                lds_cptr xa = (lds_cptr)(lds + SS_XW + pb * 8192 + vfn), b0 = (lds_cptr)(lds + SS_BM + tb0), b1 = (lds_cptr)(lds + SS_BM + tb1);
#pragma unroll
                for (int ks = 0; ks < 8; ++ks) {
                    const s16x4 alo = vtr(xa + ks * 1024), ahi = vtr(xa + ks * 1024 + 256);
                    const s16x4 blo = vtr(b0 + ks * 4096), bhi = vtr(b1 + ks * 4096);
                    const bf16x8 af = (bf16x8){alo[0], alo[1], alo[2], alo[3], ahi[0], ahi[1], ahi[2], ahi[3]}, bq = (bf16x8){blo[0], blo[1], blo[2], blo[3], bhi[0], bhi[1], bhi[2], bhi[3]};
                    Hacc = MFMA32(af, bq, Hacc);
                }
            }
        }
        __syncthreads();
        if (c < 15) {
            LAS unsigned char* hb = lds + SS_H + 8192 * pb + 512 * lb + (r32 & 7) * 2;
#pragma unroll
            for (int r = 0; r < 16; ++r) { const int p = crow(r, hh); *(LAS unsigned short*)(hb + rowoff_a(p) + 16 * (((r32 >> 3) & 3) ^ ((p >> 2) & 3))) = (unsigned short)f2bf(Hacc[r]); }
            SS_PART0();
        }
        {
            const int row = tid >> 2, qt = tid & 3;
            oy0 = *(const LAS u32x4*)(lds + SS_ZT + row * SS_ZP + qt * 32); oy1 = *(const LAS u32x4*)(lds + SS_ZT + row * SS_ZP + qt * 32 + 16);
            float s = 0.f;
#pragma unroll
            for (int e = 0; e < 4; ++e) { const float a0 = bf2f(oy0[e] & 0xffffu), a1 = bf2f(oy0[e] >> 16), a2 = bf2f(oy1[e] & 0xffffu), a3 = bf2f(oy1[e] >> 16); s += (a0 * a0 + a1 * a1) + (a2 * a2 + a3 * a3); }
            s += __shfl_xor(s, 1); s += __shfl_xor(s, 2); oss = s;
        }
        __syncthreads();
    }
    SS_STORE_OUT(15);
#undef SS_STORE_OUT
#undef SS_PREFETCH1
#undef SS_ROLES
#undef SS_BLD
#undef SS_PREFETCHD
#undef SS_PREFETCH2
#undef SS_PART0
}

__device__ __forceinline__ void bc_prepass(const bf16_t* proj, const float* conv_w, const float* conv_b, bf16_t* bcact, int gthread, int nthreads) {
    for (int it = gthread; it < (MROWS / 8) * 64; it += nthreads) {
        const int cc = it & 63, run = it >> 6, row0 = run * 8, ch = 1024 + cc * 8;
        const bf16_t* src = proj + (size_t)row0 * PROJ_P + CXS + ch;
        u32x4 raw[11];
#pragma unroll
        for (int i = 0; i < 11; ++i) { const bool ok = ((row0 & (SEQ - 1)) + i >= 3); raw[i] = ok ? *(const u32x4*)(src + (ptrdiff_t)(i - 3) * PROJ_P) : (u32x4){0u, 0u, 0u, 0u}; }
        f32x4 w[4][2], bs[2];
#pragma unroll
        for (int j = 0; j < 4; ++j) { w[j][0] = *(const f32x4*)(conv_w + j * 1536 + ch); w[j][1] = *(const f32x4*)(conv_w + j * 1536 + ch + 4); }
        bs[0] = *(const f32x4*)(conv_b + ch); bs[1] = *(const f32x4*)(conv_b + ch + 4);
#pragma unroll
        for (int r = 0; r < 8; ++r) {
            float v[8];
#pragma unroll
            for (int e = 0; e < 8; ++e) v[e] = bs[e >> 2][e & 3];
#pragma unroll
            for (int j = 0; j < 4; ++j)
#pragma unroll
                for (int e = 0; e < 4; ++e) { const unsigned wd = raw[r + j][e]; v[2 * e] += w[j][(2 * e) >> 2][(2 * e) & 3] * bf2f(wd & 0xffffu); v[2 * e + 1] += w[j][(2 * e + 1) >> 2][(2 * e + 1) & 3] * bf2f(wd >> 16); }
            u32x4 o;
#pragma unroll
            for (int e = 0; e < 4; ++e) o[e] = cvtpk(silu_fast(v[2 * e]), silu_fast(v[2 * e + 1]));
            *(u32x4*)(bcact + (size_t)(row0 + r) * 512 + cc * 8) = o;
        }
    }
}

#include <hip/hip_cooperative_groups.h>
namespace cg = cooperative_groups;
#define GAS __attribute__((address_space(1)))
#define LDS_WAIT() asm volatile("s_waitcnt lgkmcnt(0)" ::: "memory")
constexpr int NWAVES = 8, NTHREADS = NWAVES * 64;
constexpr int RING_BYTES = 131072, LDS_BYTES = 147456;
constexpr int NPHASE = 9, LDS_BARW = LDS_BYTES - 64;

typedef GAS unsigned gu32;
#define RLX_AGENT __ATOMIC_RELAXED, __HIP_MEMORY_SCOPE_AGENT
#define XB_TMO      128
#define XB_XCNT(j)  (256  + 64 * (j))
#define XB_XSUB(j)  (1280 + 64 * (j))
#define XB_XGEN(j)  (2304 + 64 * (j))
#define XB_TOP      3328
#define XB_TOPGEN   3392
#define XCD_BAR_WORDS 3456
#define XB_SPIN_CAP (1u << 18)

__device__ __forceinline__ unsigned xb_ld(unsigned* p)              { return __hip_atomic_load(p, __ATOMIC_RELAXED, __HIP_MEMORY_SCOPE_AGENT); }
__device__ __forceinline__ unsigned xb_add(unsigned* p, unsigned v) { return __hip_atomic_fetch_add(p, v, __ATOMIC_RELAXED, __HIP_MEMORY_SCOPE_AGENT); }
__device__ __forceinline__ unsigned xb_xcc_id() { return (unsigned)__builtin_amdgcn_s_getreg((3 << 11) | 20) & 0xFu; }
#define XB_SPIN(cond, bar) do { unsigned _sp = 0; while (cond) { __builtin_amdgcn_s_sleep(1); \
    if ((++_sp & 255u) == 0u) { if (xb_ld(&(bar)[XB_TMO])) break; if (_sp > XB_SPIN_CAP) { atomicAdd(&(bar)[XB_TMO], 1u); break; } } } } while (0)

struct XcdBarrier {
    unsigned* bar; unsigned x;
    volatile LAS unsigned* st;
};

__device__ __forceinline__ XcdBarrier xcd_barrier_post(unsigned* bar, volatile LAS unsigned* st) {
    XcdBarrier b; b.bar = bar; b.x = xb_xcc_id(); b.st = st;
    if (threadIdx.x == 0) (void)xb_add(&bar[XB_XCNT(b.x)], 1u);
    return b;
}
__device__ __forceinline__ void xcd_barrier_complete(unsigned* bar, unsigned x, unsigned& nloc, unsigned& nx) {
    const unsigned G = gridDim.x * gridDim.y * gridDim.z;
    unsigned sum, cnt, mine, sp = 0u;
    for (;;) {
        sum = 0u; cnt = 0u; mine = 0u;
#pragma unroll
        for (unsigned j = 0; j < 16; ++j) { const unsigned c = xb_ld(&bar[XB_XCNT(j)]); sum += c; cnt += (c > 0u) ? 1u : 0u; mine = (j == x) ? c : mine; }
        if (sum == G) break;
        __builtin_amdgcn_s_sleep(1);
        if ((++sp & 255u) == 0u) { if (xb_ld(&bar[XB_TMO])) break; if (sp > XB_SPIN_CAP) { atomicAdd(&bar[XB_TMO], 1u); break; } }
    }
    nloc = mine > 0u ? mine : 1u; nx = cnt > 0u ? cnt : 1u;
}

__device__ __forceinline__ void xcd_barrier(const XcdBarrier& b) {
    asm volatile("s_waitcnt vmcnt(0)" ::: "memory");
    __syncthreads();
    if (threadIdx.x == 0) {
        unsigned* bar = b.bar;
        __builtin_amdgcn_s_waitcnt(0);
        unsigned nloc = b.st[0], nx = b.st[1];
        if (nloc == 0u) { xcd_barrier_complete(bar, b.x, nloc, nx); b.st[0] = nloc; b.st[1] = nx; }
        const unsigned old = xb_add(&bar[XB_XSUB(b.x)], 1u);
        const unsigned gen = old / nloc;
        if (old + 1u == (gen + 1u) * nloc) {
            __builtin_amdgcn_fence(__ATOMIC_RELEASE, "agent");
            asm volatile("s_waitcnt vmcnt(0)" ::: "memory");
            const unsigned og = xb_add(&bar[XB_TOP], 1u);
            const unsigned tg = og / nx;
            if (og + 1u == (tg + 1u) * nx) xb_add(&bar[XB_TOPGEN], 1u);
            else XB_SPIN(xb_ld(&bar[XB_TOPGEN]) == tg, bar);
            __builtin_amdgcn_fence(__ATOMIC_ACQUIRE, "agent");
            xb_add(&bar[XB_XGEN(b.x)], 1u);
            asm volatile("s_waitcnt vmcnt(0)" ::: "memory");
        } else {
            XB_SPIN(xb_ld(&bar[XB_XGEN(b.x)]) == gen, bar);
            __builtin_amdgcn_fence(__ATOMIC_ACQUIRE, "agent");
            asm volatile("s_waitcnt vmcnt(0)" ::: "memory");
        }
    }
    __syncthreads();
}

struct Args { const float* in[21]; float* out; unsigned char* ws; unsigned char* alt; unsigned char* alt2; int ph_lo, ph_hi, fast, altpitch, skip, pad; };

__device__ __forceinline__ void p0_transpose_item(const float* W, const float* s, int K, int N, bf16_t* WT, LAS float* scr, int item, int nblk, int lane) {
    const int kb = item / nblk, nb = item % nblk, k0 = 64 * kb, n0 = 32 * nb, n = n0 + (lane & 31);
    const bool ok = n < N;
    float wv[32];
#pragma unroll
    for (int i = 0; i < 32; ++i) { const int kk = 2 * i + (lane >> 5); wv[i] = W[(size_t)(k0 + kk) * N + (ok ? n : 0)]; }
#pragma unroll
    for (int i = 0; i < 32; ++i) { const int kk = 2 * i + (lane >> 5); float v = ok ? wv[i] : 0.f; if (s) v *= s[k0 + kk]; scr[kk * 33 + (lane & 31)] = v; }
    LDS_WAIT(); asm volatile("" ::: "memory");
    const int c = lane & 7;
#pragma unroll
    for (int j = 0; j < 4; ++j) { const int nn = (lane >> 3) + 8 * j; const LAS float* sp = scr + (8 * c) * 33 + nn;
        u32x4 o; o.x = pk2(sp[0 * 33], sp[1 * 33]); o.y = pk2(sp[2 * 33], sp[3 * 33]); o.z = pk2(sp[4 * 33], sp[5 * 33]); o.w = pk2(sp[6 * 33], sp[7 * 33]);
        *(u32x4*)(WT + (size_t)(n0 + nn) * K + k0 + 8 * c) = o; }
    LDS_WAIT(); asm volatile("" ::: "memory");
}

__global__ void __launch_bounds__(NTHREADS, 2) mega(Args a) {
    extern __shared__ __attribute__((aligned(16))) unsigned char lds[];
    cg::grid_group grid = cg::this_grid();
    const int tid = threadIdx.x, lane = tid & 63, wave = __builtin_amdgcn_readfirstlane(tid >> 6);
    const int G = gridDim.x, bx = blockIdx.x, vcu = (G % 8 == 0) ? (bx % 8) * (G / 8) + bx / 8 : bx;
    const int gw = vcu * NWAVES + wave, NGW = G * NWAVES;
    unsigned char* ws = a.ws;
    const float* x = a.in[0];
    bf16_t* WA = (bf16_t*)(ws + WS_WA); bf16_t* WOA = (bf16_t*)(ws + WS_WOA); bf16_t* WC = (bf16_t*)(ws + WS_WC); bf16_t* WOC = (bf16_t*)(ws + WS_WOC);
    float* DT = (float*)(ws + WS_DT); float* SSQ = (float*)(ws + WS_SSQ); float* RSTD0 = (float*)(ws + WS_RSTD0); float* SSQ1 = (float*)(ws + WS_SSQ1);
    bf16_t* PROJ = (bf16_t*)(ws + WS_PROJ); float* X1 = (float*)(ws + WS_X1); bf16_t* XB1 = (bf16_t*)(ws + WS_XB1); bf16_t* PROJC = (bf16_t*)(ws + WS_PROJC); bf16_t* OGb = (bf16_t*)(ws + WS_OG);
    bf16_t* XB = (bf16_t*)a.out; bf16_t* Y = (bf16_t*)a.out;
    const int lo = a.ph_lo, hi = a.ph_hi;
#define IN(k) (lo <= (k) && (k) < hi)
#define SEAM(k) do { if (IN(k) && IN((k) + 1)) { if (!bar_ready) { grid.sync(); bar = xcd_barrier_post(barw, (volatile LAS unsigned*)((LAS unsigned char*)lds + LDS_BARW)); bar_ready = true; } else xcd_barrier(bar); } } while (0)
    unsigned* barw = (unsigned*)(ws + WS_CTL + 4096);
    for (int i = tid; i < XCD_BAR_WORDS; i += NTHREADS) if (bx == 0) __hip_atomic_store(barw + i, 0u, RLX_AGENT);
    if (tid < 2) *((LAS unsigned*)((LAS unsigned char*)lds + LDS_BARW) + tid) = 0u;
    __syncthreads();
    XcdBarrier bar; bar.bar = barw; bar.x = 0; bar.st = nullptr; bool bar_ready = false;
#define MIDBAR() do { if (!bar_ready) { grid.sync(); bar = xcd_barrier_post(barw, (volatile LAS unsigned*)((LAS unsigned char*)lds + LDS_BARW)); bar_ready = true; } else xcd_barrier(bar); } while (0)
#define REP(k) for (int rep_ = 0; rep_ <= ((REP_MASK >> (k)) & 1); ++rep_)

    if (IN(0)) REP(0) {
        LAS float* scr = (LAS float*)((LAS unsigned char*)lds + wave * 16384);
        constexpr int I_A = (DM / 64) * (NA_PAD / 32), I_OA = (2048 / 64) * (DM / 32), I_C = (DM / 64) * (ODD_IN / 32), I_OC = (DM / 64) * (DM / 32);
        for (int it = gw; it < I_A + I_OA + I_C + I_OC; it += NGW) {
            int r = it;
            if (r < I_A) { p0_transpose_item(a.in[2], a.in[1], DM, EVEN_IN, WA, scr, r, NA_PAD / 32, lane); continue; } r -= I_A;
            if (r < I_OA) { p0_transpose_item(a.in[14], nullptr, 2048, DM, WOA, scr, r, DM / 32, lane); continue; } r -= I_OA;
            if (r < I_C) { p0_transpose_item(a.in[16], a.in[15], DM, ODD_IN, WC, scr, r, ODD_IN / 32, lane); continue; } r -= I_C;
            p0_transpose_item(a.in[19], nullptr, DM, DM, WOC, scr, r, DM / 32, lane);
        }
        for (int m0 = gw; m0 < MROWS; m0 += 4 * NGW) {
            f32x4 v[4][4];
#pragma unroll
            for (int q = 0; q < 4; ++q) { const int m = m0 + q * NGW; if (m < MROWS) { const f32x4* xr = (const f32x4*)(x + (size_t)m * DM) + lane;
#pragma unroll
                for (int j = 0; j < 4; ++j) v[q][j] = __builtin_nontemporal_load(xr + 64 * j); } }
#pragma unroll
            for (int q = 0; q < 4; ++q) { const int m = m0 + q * NGW; if (m < MROWS) { float s = 0.f;
                unsigned long long* o8 = (unsigned long long*)(XB + (size_t)m * DM) + lane;
#pragma unroll
                for (int j = 0; j < 4; ++j) { const f32x4 w = v[q][j]; s += (w.x * w.x + w.y * w.y) + (w.z * w.z + w.w * w.w); o8[64 * j] = (unsigned long long)pk2(w.x, w.y) | ((unsigned long long)pk2(w.z, w.w) << 32); }
                s = wave_sum(s);
                if (lane == 0) RSTD0[m] = 1.f / sqrtf(s * (1.f / DM) + EPS); } }
        }
    }
    SEAM(0);
    if (IN(1)) REP(1) {
        pg8::Gemm g{XB, WA, MROWS, NA_PAD, DM}; pg8::StaticOrder S; S.init(MROWS, NA_PAD, G, bx);
        pg8::EpiProjA E{PROJ, DT, RSTD0, PROJ_P, PROJ_P / 256, 4, 0.125f * LOG2E};
        pg8::gemm_phase<pg8::EpiProjA, pg8::StaticOrder, true, true>((LAS unsigned char*)lds, g, S, E);
    }
    SEAM(1);
    if (IN(2)) {
        bf16_t* BCA = (bf16_t*)(ws + WS_BC);
        if (!(a.skip & 2) && (a.fast & 2)) bc_prepass(PROJ, a.in[3], a.in[4], BCA, vcu * NTHREADS + tid, G * NTHREADS);
        if (a.skip & 1) { }
        else if (a.fast & 1) REP(2) {
            float s1 = 0.f, s2 = 0.f; for (int i = 0; i < 64; ++i) { s1 += a.in[9][i] * a.in[10][i]; s2 += a.in[11][i] * a.in[12][i]; }
            const float lam = __expf(s1) - __expf(s2) + LAMBDA_INIT;
            bf16_t* Yo = a.alt ? (bf16_t*)a.alt : Y; const int yp = a.alt ? a.altpitch : 2048;
            for (int ug = vcu; ug < 256; ug += G) { const int grp = ug >> 4, j = ug & 15;
                for (int s = 0; s < 8; ++s) { const int bh = grp * 8 + s, qblk = (s & 1) ? 15 - j : j; fast_diffattn_unit(bh >> 3, bh & 7, qblk, (LAS unsigned char*)lds, PROJ, lam, a.in[13], Yo, yp); } }
        } else
        for (int u = bx; u < 2048; u += G) slow_diffattn_unit(u, tid, PROJ, a.in[9], a.in[10], a.in[11], a.in[12], a.in[13], Y);
        if (!(a.skip & 2) && (a.fast & 2)) MIDBAR();
        if (a.skip & 2) { }
        else if (a.fast & 2) REP(3) { const bool dbg = a.alt2 != nullptr; bf16_t* Yo = dbg ? (bf16_t*)a.alt : Y;
            for (int u = vcu; u < 256; u += G) fast_ssd_unit(u >> 4, u & 15, (LAS unsigned char*)lds, PROJ, DT, a.in[3], a.in[4], a.in[5], a.in[6], a.in[7], Yo, dbg ? a.altpitch : 2048, dbg ? 0 : 1024, dbg ? (float*)a.alt2 : SSQ, BCA); }
        else
        for (int pr = bx; pr < 128; pr += G) slow_ssd_pair(pr, tid, (LAS float*)lds, PROJ, DT, a.in[3], a.in[4], a.in[5], a.in[6], a.in[7], Y, SSQ);
    }
    SEAM(2);
    if (IN(3)) {
        const float* w = a.in[8];
        f32x4 wv[2][2];
#pragma unroll
        for (int g = 0; g < 2; ++g) { wv[g][0] = *(const f32x4*)(w + g * 512 + lane * 8); wv[g][1] = *(const f32x4*)(w + g * 512 + lane * 8 + 4); }
        for (int m0 = gw; m0 < MROWS; m0 += 4 * NGW) {
            u32x4 yv[4][2]; f32x4 sv[4][4];
#pragma unroll
            for (int q = 0; q < 4; ++q) { const int m = m0 + q * NGW; if (m < MROWS) {
#pragma unroll
                for (int g = 0; g < 2; ++g) yv[q][g] = *((const u32x4*)(Y + (size_t)m * 2048 + 1024 + g * 512) + lane);
#pragma unroll
                for (int i = 0; i < 4; ++i) sv[q][i] = *((const f32x4*)(SSQ + (size_t)m * 16) + i); } }
#pragma unroll
            for (int q = 0; q < 4; ++q) { const int m = m0 + q * NGW; if (m < MROWS) {
#pragma unroll
                for (int g = 0; g < 2; ++g) {
                    const f32x4 sa = sv[q][2 * g], sb = sv[q][2 * g + 1];
                    const float s = sa[0] + sa[1] + sa[2] + sa[3] + sb[0] + sb[1] + sb[2] + sb[3];
                    const float r = 1.f / sqrtf(s * (1.f / 512.f) + EPS);
                    u32x4 v = yv[q][g];
#pragma unroll
                    for (int i = 0; i < 4; ++i) v[i] = pk2(bf2f(v[i] & 0xffffu) * r * wv[g][i >> 1][(2 * i) & 3], bf2f(v[i] >> 16) * r * wv[g][i >> 1][(2 * i + 1) & 3]);
                    *((u32x4*)(Y + (size_t)m * 2048 + 1024 + g * 512) + lane) = v;
                } } }
        }
    }
    SEAM(3);
    if (IN(4)) {
        pg8::Gemm g{Y, WOA, MROWS, DM, 2048}; pg8::StaticOrder S; S.init(MROWS, DM, G, bx);
        pg8::EpiRes E{x, X1, XB1, SSQ1, DM};
        pg8::gemm_phase<pg8::EpiRes, pg8::StaticOrder, true, true>((LAS unsigned char*)lds, g, S, E);
    }
    SEAM(4);
    if (IN(5)) REP(5) {
        pg8::Gemm g{XB1, WC, MROWS, ODD_IN, DM}; pg8::StaticOrder S; S.init(MROWS, ODD_IN, G, bx);
        pg8::EpiProjC E{PROJC, SSQ1, a.in[17], ODD_IN, 1.f / DM, EPS, 4, 0.125f * LOG2E};
        pg8::gemm_phase<pg8::EpiProjC, pg8::StaticOrder, true, true>((LAS unsigned char*)lds, g, S, E);
    }
    SEAM(5);
    if (IN(6)) {
        if (a.fast & 4) REP(6) { bf16_t* Oo = a.alt ? (bf16_t*)a.alt : OGb; const int op = a.alt ? a.altpitch : DM;
            for (int ug = vcu; ug < 256; ug += G) fast_swa_group(ug, (LAS unsigned char*)lds, PROJC, a.in[18], Oo, op); }
        else
        for (int u = bx; u < 1024; u += G) slow_swa_unit(u, tid, PROJC, a.in[18], OGb);
    }
    SEAM(6);
    if (IN(7)) {
        pg8::Gemm g{OGb, WOC, MROWS, DM, DM}; pg8::StaticOrder S; S.init(MROWS, DM, G, bx);
        pg8::EpiRes E{X1, X1, nullptr, nullptr, DM};
        pg8::gemm_phase<pg8::EpiRes, pg8::StaticOrder, true, true>((LAS unsigned char*)lds, g, S, E);
    }
    SEAM(7);
    if (IN(8)) REP(8) {
        const f32x4* wr = (const f32x4*)a.in[20] + lane;
        const f32x4 w0 = wr[0], w1 = wr[64], w2 = wr[128], w3 = wr[192];
        for (int m0 = gw; m0 < MROWS; m0 += 4 * NGW) {
            f32x4 v[4][4];
#pragma unroll
            for (int q = 0; q < 4; ++q) { const int m = m0 + q * NGW; if (m < MROWS) { const f32x4* xr = (const f32x4*)(X1 + (size_t)m * DM) + lane;
#pragma unroll
                for (int j = 0; j < 4; ++j) v[q][j] = __builtin_nontemporal_load(xr + 64 * j); } }
#pragma unroll
            for (int q = 0; q < 4; ++q) { const int m = m0 + q * NGW; if (m < MROWS) { float s = 0.f;
#pragma unroll
                for (int j = 0; j < 4; ++j) s += (v[q][j].x * v[q][j].x + v[q][j].y * v[q][j].y) + (v[q][j].z * v[q][j].z + v[q][j].w * v[q][j].w);
                s = wave_sum(s); const float r = 1.f / sqrtf(s * (1.f / DM) + EPS);
                f32x4* o = (f32x4*)(a.out + (size_t)m * DM) + lane;
                __builtin_nontemporal_store(v[q][0] * r * w0, o); __builtin_nontemporal_store(v[q][1] * r * w1, o + 64); __builtin_nontemporal_store(v[q][2] * r * w2, o + 128); __builtin_nontemporal_store(v[q][3] * r * w3, o + 192); } }
        }
    }
#undef IN
#undef SEAM
#undef REP
}

#ifndef DEBUG_CMP
#define DEBUG_CMP 0
#endif
#ifndef FAST_MASK
#define FAST_MASK 7
#endif
#ifndef CMP_R0
#define CMP_R0 0
#define CMP_R1 2048
#define CMP_C0 0
#define CMP_C1 1024
#endif
constexpr size_t WS_ALT = 448 * MiB;
__global__ void __launch_bounds__(256) k_cmp_bf16(const bf16_t* A, int pa, const bf16_t* B, int pb, int ncol, int r0, int r1, int c0, int c1, float* met) {
    float sd = 0.f, sr = 0.f;
    for (size_t i = (size_t)blockIdx.x * 256 + threadIdx.x; i < (size_t)MROWS * ncol; i += (size_t)gridDim.x * 256) {
        const int row = (int)(i / ncol), col = (int)(i % ncol), sp = row % SEQ;
        if (sp < r0 || sp >= r1 || col < c0 || col >= c1) continue;
        const float x = bf2f(A[(size_t)row * pa + col]), y = bf2f(B[(size_t)row * pb + col]); const float d = x - y;
        sd += (d == d) ? d * d : 1e6f; sr += x * x;
    }
    sd = wave_sum(sd); sr = wave_sum(sr);
    if ((threadIdx.x & 63) == 0) { atomicAdd(met, sd); atomicAdd(met + 1, sr); }
}
__global__ void __launch_bounds__(256) k_inject(float* out, const float* met) {
    const float rel = fminf(sqrtf(met[0] / fmaxf(met[1], 1e-30f)), 3.f);
    f32x4* o = (f32x4*)out + (size_t)blockIdx.x * 256 + threadIdx.x; *o = *o * (1.f + rel);
}
static int g_grid = 0;
static void launch_mega(const Args& base, int lo, int hi, hipStream_t stream) {
    Args a = base; a.ph_lo = lo; a.ph_hi = hi; void* params[] = {&a};
    hipError_t e = hipLaunchCooperativeKernel((const void*)mega, dim3(g_grid), dim3(NTHREADS), params, LDS_BYTES, stream);
    if (e != hipSuccess) fprintf(stderr, "kernel_launch: cooperative launch [%d,%d) failed: %s (grid %d)\n", lo, hi, hipGetErrorString(e), g_grid);
}
extern "C" void kernel_launch(void* const* d_in, const int* in_sizes, int n_in, void* d_out, int out_size, void* d_ws, size_t ws_size, hipStream_t stream) {
    if (n_in != 21 || in_sizes[0] != MROWS * DM || out_size != MROWS * DM || ws_size < WS_END) { fprintf(stderr, "kernel_launch: unexpected shapes (n_in %d, ws %zu)\n", n_in, ws_size); return; }
    if (g_grid == 0) {
        int dev = 0, cus = 0, per_cu = 0;
        (void)hipGetDevice(&dev); (void)hipDeviceGetAttribute(&cus, hipDeviceAttributeMultiprocessorCount, dev);
        if (hipFuncSetAttribute((const void*)mega, hipFuncAttributeMaxDynamicSharedMemorySize, LDS_BYTES) != hipSuccess) { fprintf(stderr, "kernel_launch: hipFuncSetAttribute failed\n"); g_grid = -1; return; }
        if (hipOccupancyMaxActiveBlocksPerMultiprocessor(&per_cu, (const void*)mega, NTHREADS, LDS_BYTES) != hipSuccess || per_cu < 1) { fprintf(stderr, "kernel_launch: occupancy query says %d blocks per CU\n", per_cu); g_grid = -1; return; }
        g_grid = cus;
        fprintf(stderr, "kernel_launch: %d CUs, %d blocks/CU admitted, grid %d\n", cus, per_cu, g_grid);
    }
    if (g_grid < 0) return;
    unsigned char* ws = (unsigned char*)d_ws;
    Args a{}; for (int i = 0; i < 21; ++i) a.in[i] = (const float*)d_in[i];
    a.out = (float*)d_out; a.ws = ws; a.fast = FAST_MASK;
#if DEBUG_CMP == 0
    launch_mega(a, 0, NPHASE, stream);
#else
    float* met = (float*)(ws + WS_CTL);
    (void)hipMemsetAsync(met, 0, 256, stream);
    a.fast = 0; launch_mega(a, 0, 3, stream);
    Args f = a; f.fast = FAST_MASK;
#if DEBUG_CMP == 1
    f.alt = ws + WS_ALT; f.altpitch = 1024; launch_mega(f, 2, 3, stream);
    k_cmp_bf16<<<1024, 256, 0, stream>>>((const bf16_t*)d_out, 2048, (const bf16_t*)(ws + WS_ALT), 1024, 1024, CMP_R0, CMP_R1, CMP_C0, CMP_C1, met);
#endif
#if DEBUG_CMP == 2
    f.alt = ws + WS_ALT; f.altpitch = 1024; f.alt2 = ws + WS_RSTD0; f.skip = 1; launch_mega(f, 2, 3, stream);
    k_cmp_bf16<<<1024, 256, 0, stream>>>((const bf16_t*)d_out + 1024, 2048, (const bf16_t*)(ws + WS_ALT), 1024, 1024, CMP_R0, CMP_R1, CMP_C0, CMP_C1, met);
#endif
    launch_mega(a, 3, NPHASE, stream);
    k_inject<<<MROWS * DM / 4 / 256, 256, 0, stream>>>((float*)d_out, met);
#endif
}
```
